# Optimizing an MI355X kernel written in HIP

```python
import jax, jax.numpy as jnp
from jax import lax
import numpy as np

D_MODEL = 1024
BATCH = 8
SEQ = 2048
DEPTH = 1

CHUNK = 64
D_CONV = 512
CONV_WIDTH = 31
N_HEADS = 8
HEAD_DIM = 64
D_ATTN = N_HEADS * HEAD_DIM
D_MIX = D_CONV + D_ATTN
Q_BLOCK = 128
D_FF = 2816
EPS = 1e-6
N_IN = 2 * D_CONV + 3 * D_ATTN + N_HEADS

kernel_name = "hybrid_conv_fox_macaron_block"


def rms_norm(x, g):
    xf = x.astype(jnp.float32)
    y = xf * lax.rsqrt(jnp.mean(xf * xf, axis=-1, keepdims=True) + EPS)
    return (y * g.astype(jnp.float32)).astype(x.dtype)


def layer_norm(x, g, b):
    xf = x.astype(jnp.float32)
    mu = jnp.mean(xf, axis=-1, keepdims=True)
    xc = xf - mu
    y = xc * lax.rsqrt(jnp.mean(xc * xc, axis=-1, keepdims=True) + EPS)
    return (y * g.astype(jnp.float32) + b.astype(jnp.float32)).astype(x.dtype)


def swiglu_ffn(h, w13, w2):
    gate, up = jnp.split(h @ w13, 2, axis=-1)
    return (jax.nn.silu(gate) * up) @ w2


def conv_module(a, g, conv_w, conv_b, ln_g, ln_b):
    u = a * jax.nn.sigmoid(g)
    u_pad = jnp.pad(u, ((0, 0), (CONV_WIDTH - 1, 0), (0, 0)))
    y = lax.conv_general_dilated(
        u_pad, conv_w[:, None, :].astype(u.dtype), window_strides=(1,), padding="VALID",
        dimension_numbers=("NWC", "WIO", "NWC"), feature_group_count=D_CONV)
    y = y + conv_b.astype(y.dtype)
    y = layer_norm(y, ln_g, ln_b)
    return jax.nn.silu(y)


def forgetting_attention(q, k, v, f_logit):
    seq = q.shape[1]
    log_f = jax.nn.log_sigmoid(f_logit.astype(jnp.float32))
    cum = jnp.cumsum(log_f, axis=1).transpose(0, 2, 1)
    scale = HEAD_DIM ** -0.5
    outs = []
    for i in range(seq // Q_BLOCK):
        q0, q1 = i * Q_BLOCK, (i + 1) * Q_BLOCK
        qb, kb, vb = q[:, q0:q1], k[:, :q1], v[:, :q1]
        s = jnp.einsum("bqhd,bkhd->bhqk", qb, kb, preferred_element_type=jnp.float32) * scale
        s = s + cum[:, :, q0:q1, None] - cum[:, :, None, :q1]
        qpos = jnp.arange(q0, q1)
        kpos = jnp.arange(q1)
        s = jnp.where(kpos[None, :] <= qpos[:, None], s, -jnp.inf)
        p = jax.nn.softmax(s, axis=-1)
        outs.append(jnp.einsum("bhqk,bkhd->bqhd", p.astype(vb.dtype), vb))
    return jnp.concatenate(outs, axis=1)


def setup_inputs(seed: int = 0) -> dict:
    key = jax.random.key(seed)
    ks = jax.random.split(key, 24)
    f32 = jnp.float32

    def nrm(k, shape, scale):
        return jax.random.normal(k, shape, f32) * scale

    def gain(k, shape):
        return 1.0 + 0.05 * jax.random.normal(k, shape, f32)

    L = DEPTH
    return {
        "x": jax.random.normal(ks[0], (BATCH, SEQ, D_MODEL), f32),
        "ffn1_norm": gain(ks[1], (L, D_MODEL)),
        "ffn1_w13": nrm(ks[2], (L, D_MODEL, 2 * D_FF), D_MODEL ** -0.5),
        "ffn1_w2": nrm(ks[3], (L, D_FF, D_MODEL), D_FF ** -0.5),
        "mix_norm": gain(ks[4], (L, D_MODEL)),
        "w_in": nrm(ks[5], (L, D_MODEL, N_IN), D_MODEL ** -0.5),
        "conv_w": nrm(ks[6], (L, CONV_WIDTH, D_CONV), CONV_WIDTH ** -0.5),
        "conv_b": nrm(ks[7], (L, D_CONV), 0.02),
        "conv_ln_g": gain(ks[8], (L, D_CONV)),
        "conv_ln_b": nrm(ks[9], (L, D_CONV), 0.02),
        "forget_b": jax.random.uniform(ks[10], (L, N_HEADS), f32, minval=1.0, maxval=4.0),
        "out_norm_conv": gain(ks[11], (L, D_CONV)),
        "out_norm_attn": gain(ks[12], (L, D_ATTN)),
        "w_out": nrm(ks[13], (L, D_MIX, D_MODEL), D_MIX ** -0.5),
        "ffn2_norm": gain(ks[14], (L, D_MODEL)),
        "ffn2_w13": nrm(ks[15], (L, D_MODEL, 2 * D_FF), D_MODEL ** -0.5),
        "ffn2_w2": nrm(ks[16], (L, D_FF, D_MODEL), D_FF ** -0.5),
        "final_norm": gain(ks[17], (D_MODEL,)),
    }


def reference(x, ffn1_norm, ffn1_w13, ffn1_w2, mix_norm, w_in, conv_w, conv_b, conv_ln_g,
              conv_ln_b, forget_b, out_norm_conv, out_norm_attn, w_out, ffn2_norm, ffn2_w13,
              ffn2_w2, final_norm):
    bsz, seq, _ = x.shape
    splits = [D_CONV, 2 * D_CONV, 2 * D_CONV + D_ATTN, 2 * D_CONV + 2 * D_ATTN,
              2 * D_CONV + 3 * D_ATTN]
    for l in range(DEPTH):
        x = x + 0.5 * swiglu_ffn(rms_norm(x, ffn1_norm[l]), ffn1_w13[l], ffn1_w2[l])

        h = rms_norm(x, mix_norm[l])
        proj = h @ w_in[l]
        a, g, q, k, v, fl = jnp.split(proj, splits, axis=-1)

        y_conv = conv_module(a, g, conv_w[l], conv_b[l], conv_ln_g[l], conv_ln_b[l])

        heads = (bsz, seq, N_HEADS, HEAD_DIM)
        y_attn = forgetting_attention(q.reshape(heads), k.reshape(heads), v.reshape(heads),
                                      fl + forget_b[l].astype(fl.dtype))
        y_attn = y_attn.reshape(bsz, seq, D_ATTN)

        y = jnp.concatenate([rms_norm(y_conv, out_norm_conv[l]),
                             rms_norm(y_attn, out_norm_attn[l])], axis=-1)
        x = x + y @ w_out[l]

        x = x + 0.5 * swiglu_ffn(rms_norm(x, ffn2_norm[l]), ffn2_w13[l], ffn2_w2[l])
    return rms_norm(x, final_norm)
```

```cpp
#include <hip/hip_runtime.h>
#include <cstdint>
#include <cstdio>

constexpr int D_MODEL = 1024, BATCH = 8, SEQ = 2048, M = BATCH * SEQ;
constexpr int D_CONV = 512, CONV_W = 31, NH = 8, HD = 64, D_ATTN = 512, D_FF = 2816, N_IN = 2568;
constexpr float EPS = 1e-6f;

__device__ __forceinline__ float bf2f(unsigned short b) { return __uint_as_float((unsigned)b << 16); }
__device__ __forceinline__ unsigned short f2bf(float f) { unsigned u = __float_as_uint(f); return (unsigned short)((u + 0x7fffu + ((u >> 16) & 1u)) >> 16); }
__device__ __forceinline__ float wave_sum(float v) {
#pragma unroll
    for (int o = 1; o < 64; o <<= 1) v += __shfl_xor(v, o);
    return v;
}

__global__ void k_rms_rows(const float* x, const float* g, float* out, int ncols, int ldx, int ldo, int nrows) {
    const int row = blockIdx.x * 4 + (threadIdx.x >> 6), lane = threadIdx.x & 63;
    if (row >= nrows) return;
    const float* xr = x + (size_t)row * ldx;
    float s = 0.f;
    for (int c = lane; c < ncols; c += 64) { float v = xr[c]; s += v * v; }
    s = wave_sum(s);
    const float r = rsqrtf(s / (float)ncols + EPS);
    float* o = out + (size_t)row * ldo;
    for (int c = lane; c < ncols; c += 64) o[c] = xr[c] * r * g[c];
}

template <int MODE>
__global__ void __launch_bounds__(256) k_gemm(const float* A, int lda, const unsigned short* Abf, const float* W, int ldw, int N, int K, float* C, int ldc, unsigned short* Cbf, float scale, int upoff) {
    __shared__ float As[16][68];
    __shared__ float Bs[16][68];
    __shared__ float Bs2[MODE == 1 ? 16 : 1][68];
    const int tid = threadIdx.x, tx = tid & 15, ty = tid >> 4;
    const int m0 = blockIdx.y * 64, n0 = blockIdx.x * 64;
    float acc[4][4] = {}, acc2[4][4] = {};
    for (int k0 = 0; k0 < K; k0 += 16) {
        {
            const int r = tid >> 2, kk = (tid & 3) * 4;
            float a0, a1, a2, a3;
            if (Abf) { const unsigned short* p = Abf + (size_t)(m0 + r) * lda + k0 + kk; a0 = bf2f(p[0]); a1 = bf2f(p[1]); a2 = bf2f(p[2]); a3 = bf2f(p[3]); }
            else { const float4 v = *(const float4*)(A + (size_t)(m0 + r) * lda + k0 + kk); a0 = v.x; a1 = v.y; a2 = v.z; a3 = v.w; }
            As[kk + 0][r] = a0; As[kk + 1][r] = a1; As[kk + 2][r] = a2; As[kk + 3][r] = a3;
        }
        {
            const int kk = tid >> 4, nn = (tid & 15) * 4;
            float4 v = make_float4(0.f, 0.f, 0.f, 0.f);
            if (n0 + nn < N) v = *(const float4*)(W + (size_t)(k0 + kk) * ldw + n0 + nn);
            Bs[kk][nn] = v.x; Bs[kk][nn + 1] = v.y; Bs[kk][nn + 2] = v.z; Bs[kk][nn + 3] = v.w;
            if (MODE == 1) {
                const float4 u = *(const float4*)(W + (size_t)(k0 + kk) * ldw + upoff + n0 + nn);
                Bs2[kk][nn] = u.x; Bs2[kk][nn + 1] = u.y; Bs2[kk][nn + 2] = u.z; Bs2[kk][nn + 3] = u.w;
            }
        }
        __syncthreads();
#pragma unroll
        for (int kk = 0; kk < 16; ++kk) {
            float a[4], b[4], b2[4];
#pragma unroll
            for (int i = 0; i < 4; ++i) { a[i] = As[kk][ty * 4 + i]; b[i] = Bs[kk][tx * 4 + i]; if (MODE == 1) b2[i] = Bs2[kk][tx * 4 + i]; }
#pragma unroll
            for (int i = 0; i < 4; ++i)
#pragma unroll
                for (int j = 0; j < 4; ++j) { acc[i][j] += a[i] * b[j]; if (MODE == 1) acc2[i][j] += a[i] * b2[j]; }
        }
        __syncthreads();
    }
#pragma unroll
    for (int i = 0; i < 4; ++i)
#pragma unroll
        for (int j = 0; j < 4; ++j) {
            const int m = m0 + ty * 4 + i, n = n0 + tx * 4 + j;
            if (n >= N) continue;
            if (MODE == 0) C[(size_t)m * ldc + n] = acc[i][j];
            else if (MODE == 1) { const float g = acc[i][j], u = acc2[i][j]; Cbf[(size_t)m * ldc + n] = f2bf(g / (1.f + expf(-g)) * u); }
            else C[(size_t)m * ldc + n] = C[(size_t)m * ldc + n] + scale * acc[i][j];
        }
}

__global__ void k_cumsum(const float* proj, const float* fb, float* Dc) {
    const int bh = blockIdx.x, b = bh / NH, h = bh % NH, lane = threadIdx.x;
    float loc[32]; float s = 0.f;
    for (int i = 0; i < 32; ++i) { const int t = lane * 32 + i; const float z = proj[(size_t)(b * SEQ + t) * N_IN + 2560 + h] + fb[h];
        const float ls = fminf(z, 0.f) - log1pf(expf(-fabsf(z))); s += ls; loc[i] = s; }
    float incl = s;
#pragma unroll
    for (int o = 1; o < 64; o <<= 1) { const float v = __shfl_up(incl, o); if (lane >= o) incl += v; }
    const float excl = incl - s;
    for (int i = 0; i < 32; ++i) Dc[(size_t)bh * SEQ + lane * 32 + i] = excl + loc[i];
}

__global__ void __launch_bounds__(64) k_attn(const float* proj, const float* Dc, float* yattn) {
    const int bh = blockIdx.y, b = bh / NH, h = bh % NH, q = blockIdx.x * 64 + threadIdx.x;
    const float* qp = proj + (size_t)(b * SEQ + q) * N_IN + 1024 + h * HD;
    float qv[64], o[64];
#pragma unroll
    for (int d = 0; d < 64; ++d) { qv[d] = qp[d] * 0.125f; o[d] = 0.f; }
    const float dq = Dc[(size_t)bh * SEQ + q];
    float mx = -INFINITY, l = 0.f;
    const int kend = blockIdx.x * 64 + 63;
    for (int k = 0; k <= kend; ++k) {
        const float* kp = proj + (size_t)(b * SEQ + k) * N_IN + 1536 + h * HD;
        const float* vp = proj + (size_t)(b * SEQ + k) * N_IN + 2048 + h * HD;
        float s = 0.f;
#pragma unroll
        for (int d = 0; d < 64; ++d) s += qv[d] * kp[d];
        s += dq - Dc[(size_t)bh * SEQ + k];
        if (k > q) s = -INFINITY;
        const float mn = fmaxf(mx, s);
        const float a = (mn == -INFINITY) ? 1.f : expf(mx - mn), p = (mn == -INFINITY) ? 0.f : expf(s - mn);
        l = l * a + p;
#pragma unroll
        for (int d = 0; d < 64; ++d) o[d] = o[d] * a + p * vp[d];
        mx = mn;
    }
    const float il = 1.f / l;
    float* yp = yattn + (size_t)(b * SEQ + q) * D_ATTN + h * HD;
#pragma unroll
    for (int d = 0; d < 64; ++d) yp[d] = o[d] * il;
}

__global__ void __launch_bounds__(512) k_conv_y(const float* proj, const float* cw, const float* cb, const float* lg, const float* lb, const float* gconv, const float* gattn, float* ya, float* yc) {
    __shared__ float red[8];
    const int m = blockIdx.x, b = m / SEQ, t = m % SEQ, c = threadIdx.x, wid = c >> 6, lane = c & 63;
    float acc = cb[c];
    for (int j = 0; j < CONV_W; ++j) { const int tt = t - (CONV_W - 1) + j; if (tt < 0) continue;
        const float* pr = proj + (size_t)(b * SEQ + tt) * N_IN; const float a = pr[c], g = pr[512 + c];
        acc += cw[j * D_CONV + c] * (a / (1.f + expf(-g))); }
    auto block_sum = [&](float v) -> float { v = wave_sum(v); __syncthreads(); if (lane == 0) red[wid] = v; __syncthreads(); float s = 0.f; for (int i = 0; i < 8; ++i) s += red[i]; return s; };
    const float mu = block_sum(acc) / 512.f; const float xc = acc - mu;
    const float var = block_sum(xc * xc) / 512.f;
    float v = xc * rsqrtf(var + EPS) * lg[c] + lb[c];
    v = v / (1.f + expf(-v));
    const float ms = block_sum(v * v) / 512.f;
    yc[(size_t)m * D_CONV + c] = v * rsqrtf(ms + EPS) * gconv[c];
    const float a = ya[(size_t)m * D_ATTN + c];
    const float ms2 = block_sum(a * a) / 512.f;
    ya[(size_t)m * D_ATTN + c] = a * rsqrtf(ms2 + EPS) * gattn[c];
}

extern "C" void kernel_launch(void* const* d_in, const int* in_sizes, int n_in, void* d_out, int out_size, void* d_ws, size_t ws_size, hipStream_t stream) {
    const float* x = (const float*)d_in[0];
    const float *ffn1_norm = (const float*)d_in[1], *ffn1_w13 = (const float*)d_in[2], *ffn1_w2 = (const float*)d_in[3], *mix_norm = (const float*)d_in[4], *w_in = (const float*)d_in[5];
    const float *conv_w = (const float*)d_in[6], *conv_b = (const float*)d_in[7], *ln_g = (const float*)d_in[8], *ln_b = (const float*)d_in[9], *forget_b = (const float*)d_in[10];
    const float *onc = (const float*)d_in[11], *ona = (const float*)d_in[12], *w_out = (const float*)d_in[13], *ffn2_norm = (const float*)d_in[14], *ffn2_w13 = (const float*)d_in[15], *ffn2_w2 = (const float*)d_in[16], *final_norm = (const float*)d_in[17];
    float* out = (float*)d_out; char* ws = (char*)d_ws;
    const size_t MB = 1u << 20;
    float* H = (float*)(ws);
    float* YC = (float*)(ws); float* YA = (float*)(ws + 32 * MB);
    unsigned short* ACT = (unsigned short*)(ws + 64 * MB);
    float* PROJ = (float*)(ws + 64 * MB);
    float* DC = (float*)(ws + 225 * MB);
    hipMemcpyAsync(out, x, (size_t)M * D_MODEL * 4, hipMemcpyDeviceToDevice, stream);
    k_rms_rows<<<M / 4, 256, 0, stream>>>(out, ffn1_norm, H, D_MODEL, D_MODEL, D_MODEL, M);
    k_gemm<1><<<dim3(D_FF / 64, M / 64), 256, 0, stream>>>(H, D_MODEL, nullptr, ffn1_w13, 2 * D_FF, D_FF, D_MODEL, nullptr, D_FF, ACT, 0.f, D_FF);
    k_gemm<2><<<dim3(D_MODEL / 64, M / 64), 256, 0, stream>>>(nullptr, D_FF, ACT, ffn1_w2, D_MODEL, D_MODEL, D_FF, out, D_MODEL, nullptr, 0.5f, 0);
    k_rms_rows<<<M / 4, 256, 0, stream>>>(out, mix_norm, H, D_MODEL, D_MODEL, D_MODEL, M);
    k_gemm<0><<<dim3((N_IN + 63) / 64, M / 64), 256, 0, stream>>>(H, D_MODEL, nullptr, w_in, N_IN, N_IN, D_MODEL, PROJ, N_IN, nullptr, 0.f, 0);
    k_cumsum<<<BATCH * NH, 64, 0, stream>>>(PROJ, forget_b, DC);
    k_attn<<<dim3(SEQ / 64, BATCH * NH), 64, 0, stream>>>(PROJ, DC, YA);
    k_conv_y<<<M, 512, 0, stream>>>(PROJ, conv_w, conv_b, ln_g, ln_b, onc, ona, YA, YC);
    k_gemm<2><<<dim3(D_MODEL / 64, M / 64), 256, 0, stream>>>(YC, D_CONV, nullptr, w_out, D_MODEL, D_MODEL, D_CONV, out, D_MODEL, nullptr, 1.f, 0);
    k_gemm<2><<<dim3(D_MODEL / 64, M / 64), 256, 0, stream>>>(YA, D_ATTN, nullptr, w_out + (size_t)D_CONV * D_MODEL, D_MODEL, D_MODEL, D_ATTN, out, D_MODEL, nullptr, 1.f, 0);
    k_rms_rows<<<M / 4, 256, 0, stream>>>(out, ffn2_norm, H, D_MODEL, D_MODEL, D_MODEL, M);
    k_gemm<1><<<dim3(D_FF / 64, M / 64), 256, 0, stream>>>(H, D_MODEL, nullptr, ffn2_w13, 2 * D_FF, D_FF, D_MODEL, nullptr, D_FF, ACT, 0.f, D_FF);
    k_gemm<2><<<dim3(D_MODEL / 64, M / 64), 256, 0, stream>>>(nullptr, D_FF, ACT, ffn2_w2, D_MODEL, D_MODEL, D_FF, out, D_MODEL, nullptr, 0.5f, 0);
    k_rms_rows<<<M / 4, 256, 0, stream>>>(out, final_norm, out, D_MODEL, D_MODEL, D_MODEL, M);
}
```

```cpp
#include <hip/hip_runtime.h>
#include <cstdio>
#include <cstdint>
constexpr int RSC_OFF = 131072 + 1024;
constexpr int FF_DIM = 2816;
__device__ __forceinline__ int opaque_tid() { int t = threadIdx.x; asm volatile("" : "+v"(t)); return t; }
namespace pg8 {
#define PG8_LAS __attribute__((address_space(3)))
typedef unsigned short bf16_t;
typedef short bf16x8 __attribute__((ext_vector_type(8)));
typedef float f32x4 __attribute__((ext_vector_type(4)));
typedef unsigned u32x4 __attribute__((ext_vector_type(4)));
constexpr int BM = 256, BK = 64, HALF = 128, HTB = HALF * BK * 2  , STAGE_BYTES = 8 * HTB, NXCD = 8, WGM = 8;

__host__ __device__ __forceinline__ int lds_byte(int r, int c) { const int st = (r >> 4) * 2 + (c >> 5), rr = r & 15, cc = c & 31, ob = rr * 64 + cc * 2; return st * 1024 + (ob ^ (((ob >> 9) & 1) << 5)); }
__host__ __device__ __forceinline__ void stage_rc(int b, int& R, int& C) { const int st = b / 1024, sb = b % 1024, swz = sb ^ (((sb >> 9) & 1) << 5); R = (st >> 1) * 16 + swz / 64; C = (st & 1) * 32 + (swz % 64) / 2; }
__host__ __device__ __forceinline__ int perm32(int rho) { const int n = rho >> 4, i = rho & 15; return 8 * (i >> 2) + 4 * n + (i & 3); }

struct Unit { int pm, pn; };
struct Gemm { const bf16_t* A; const bf16_t* Bt; int M, N, K; };

struct StaticOrder {
    int nM, nN, nwg, G, c;
    __host__ __device__ void init(int M, int N, int G_, int c_) { nM = M / BM; nN = N / BM; nwg = nM * nN; G = G_; c = c_; }
    __host__ __device__ bool next(int i, Unit& u) const {
        const long L = (long)i * G + c; if (L >= nwg) return false;
        int wgid = (int)L; { const int q = nwg / NXCD, r = nwg % NXCD, xcd = wgid % NXCD, off = wgid / NXCD; wgid = (xcd < r ? xcd * (q + 1) : r * (q + 1) + (xcd - r) * q) + off; }
        const int nig = WGM * nN, gid = wgid / nig, fm = gid * WGM, gsz = (nM - fm) < WGM ? (nM - fm) : WGM;
        u.pm = fm + ((wgid % nig) % gsz); u.pn = (wgid % nig) / gsz; return true;
    }
    __device__ __forceinline__ void a_ready(const Unit&) const {}
    __device__ __forceinline__ void done(const Unit&) const {}
};
__device__ __forceinline__ unsigned cvt_pk_bf16(float lo, float hi) { unsigned r; asm volatile("v_cvt_pk_bf16_f32 %0, %1, %2" : "=v"(r) : "v"(lo), "v"(hi)); return r; }
constexpr float RMS_EPS = 1e-6f, LOG2E = 1.4426950408889634f;
__device__ __forceinline__ float rs_from4(const float* ssq, int row) { const f32x4 p = *(const f32x4*)(ssq + 4 * (size_t)row); return __builtin_amdgcn_rsqf(((p[0] + p[1]) + (p[2] + p[3])) * (1.0f / 1024.0f) + RMS_EPS); }
__device__ __forceinline__ float sigmoid_f(float v) { return __builtin_amdgcn_rcpf(1.0f + __builtin_amdgcn_exp2f(-v * LOG2E)); }

template <int RSN> struct EpiSwiglu {
    static constexpr bool PERM = true, AFTER_DRAIN = false; static constexpr int MIDK = 0;
    bf16_t* O; const float* rs;
    __device__ __forceinline__ void operator()(const f32x4 (&acc)[2][2][4][2], const Unit& u, int wr, int wc, int fr, int fq) const {
        const int row0 = u.pm * BM + wr * 64 + fr, col0 = u.pn * 128 + wc * 32 + 8 * fq;
        float rsc[2][4];
#pragma unroll
        for (int ai = 0; ai < 2; ++ai)
#pragma unroll
            for (int m = 0; m < 4; ++m) { const int row = row0 + ai * HALF + m * 16; rsc[ai][m] = (RSN == 1) ? rs[row] : rs_from4(rs, row); }
#pragma unroll
        for (int ai = 0; ai < 2; ++ai)
#pragma unroll
            for (int m = 0; m < 4; ++m) { const float r = rsc[ai][m]; float h[8];
#pragma unroll
                for (int n = 0; n < 2; ++n)
#pragma unroll
                    for (int i = 0; i < 4; ++i) { const float g = acc[ai][0][m][n][i] * r, up = acc[ai][1][m][n][i] * r; h[4 * n + i] = g * up * sigmoid_f(g); }
                u32x4 w; w.x = cvt_pk_bf16(h[0], h[1]); w.y = cvt_pk_bf16(h[2], h[3]); w.z = cvt_pk_bf16(h[4], h[5]); w.w = cvt_pk_bf16(h[6], h[7]);
                *(u32x4*)(O + (size_t)(row0 + ai * HALF + m * 16) * FF_DIM + col0) = w; }
    }
};
struct EpiInProj {
    static constexpr bool PERM = true, AFTER_DRAIN = false; static constexpr int MIDK = 0;
    bf16_t* U; bf16_t* Y; bf16_t* KV; float* LF; const float* ssq; const float* fb; float qscale;
    __device__ __forceinline__ void operator()(const f32x4 (&acc)[2][2][4][2], const Unit& u, int wr, int wc, int fr, int fq) const {
        const int row0 = u.pm * BM + wr * 64 + fr, pn = u.pn;
        float rsc[2][4];
#pragma unroll
        for (int ai = 0; ai < 2; ++ai)
#pragma unroll
            for (int m = 0; m < 4; ++m) rsc[ai][m] = rs_from4(ssq, row0 + ai * HALF + m * 16);
        if (pn < 4) {
            const int col0 = pn * 128 + wc * 32 + 8 * fq;
#pragma unroll
            for (int ai = 0; ai < 2; ++ai)
#pragma unroll
                for (int m = 0; m < 4; ++m) { const float r = rsc[ai][m]; float h[8];
#pragma unroll
                    for (int n = 0; n < 2; ++n)
#pragma unroll
                        for (int i = 0; i < 4; ++i) { const float a = acc[ai][0][m][n][i] * r, g = acc[ai][1][m][n][i] * r; h[4 * n + i] = a * sigmoid_f(g); }
                    u32x4 w; w.x = cvt_pk_bf16(h[0], h[1]); w.y = cvt_pk_bf16(h[2], h[3]); w.z = cvt_pk_bf16(h[4], h[5]); w.w = cvt_pk_bf16(h[6], h[7]);
                    *(u32x4*)(U + (size_t)(row0 + ai * HALF + m * 16) * 512 + col0) = w; }
        } else if (pn < 10) {
            bf16_t* dst = (pn < 6) ? Y + (pn - 4) * 256 : (pn < 8) ? KV + (pn - 6) * 256 : KV + 512 + (pn - 8) * 256;
            const float sc = (pn < 6) ? qscale : 1.0f; const int col0 = wc * 32 + 8 * fq;
#pragma unroll
            for (int ai = 0; ai < 2; ++ai)
#pragma unroll
                for (int m = 0; m < 4; ++m) { const float r = rsc[ai][m] * sc; bf16_t* rowp = dst + (size_t)(row0 + ai * HALF + m * 16) * 1024 + col0;
#pragma unroll
                    for (int bj = 0; bj < 2; ++bj) { const f32x4 v0 = acc[ai][bj][m][0] * r, v1 = acc[ai][bj][m][1] * r;
                        u32x4 w; w.x = cvt_pk_bf16(v0[0], v0[1]); w.y = cvt_pk_bf16(v0[2], v0[3]); w.z = cvt_pk_bf16(v1[0], v1[1]); w.w = cvt_pk_bf16(v1[2], v1[3]);
                        *(u32x4*)(rowp + bj * HALF) = w; } }
        } else {
            if (wc == 0 && fq == 0) {
                float fbv[8];
#pragma unroll
                for (int h = 0; h < 8; ++h) fbv[h] = fb[h];
#pragma unroll
                for (int ai = 0; ai < 2; ++ai)
#pragma unroll
                    for (int m = 0; m < 4; ++m) { const int row = row0 + ai * HALF + m * 16; const float r = rsc[ai][m]; const int b = row >> 11, s = row & 2047;
#pragma unroll
                        for (int h = 0; h < 8; ++h) { const float z = acc[ai][0][m][h >> 2][h & 3] * r + fbv[h];
                            const float ls2 = fminf(z, 0.f) * LOG2E - __builtin_amdgcn_logf(1.0f + __builtin_amdgcn_exp2f(-fabsf(z) * LOG2E));
                            LF[((size_t)(b * 8 + h) << 11) + s] = ls2; } }
            }
        }
    }
};
template <int MIDK_> struct EpiResid {
    static constexpr bool PERM = true, AFTER_DRAIN = true; static constexpr int MIDK = MIDK_;
    const float* base; float* out; bf16_t* xb; float* ssq; float scale;
    __device__ __forceinline__ void midk(f32x4 (&acc)[2][2][4][2], int wr, int fr, PG8_LAS unsigned char* lds) const {
        const PG8_LAS float* rsc = (const PG8_LAS float*)(lds + RSC_OFF);
#pragma unroll
        for (int ai = 0; ai < 2; ++ai)
#pragma unroll
            for (int m = 0; m < 4; ++m) { const float r = rsc[ai * HALF + wr * 64 + m * 16 + fr];
#pragma unroll
                for (int bj = 0; bj < 2; ++bj)
#pragma unroll
                    for (int n = 0; n < 2; ++n) acc[ai][bj][m][n] *= r; }
    }
    __device__ __forceinline__ void fused(f32x4 (&acc)[2][2][4][2], const Unit& u, int wr, int wc, int fr, int fq, PG8_LAS unsigned char* lds, int wid, int lane) const {
        PG8_LAS float* P = (PG8_LAS float*)lds;
        const int col0 = u.pn * BM + wc * 32 + 8 * fq;
#pragma unroll
        for (int ai = 0; ai < 2; ++ai)
#pragma unroll
            for (int m = 0; m < 4; ++m) { const int rl = ai * HALF + wr * 64 + m * 16 + fr; const size_t off = (size_t)(u.pm * BM + rl) * 1024 + col0; float s = 0.f;
#pragma unroll
                for (int bj = 0; bj < 2; ++bj) { const f32x4 b0 = *(const f32x4*)(base + off + bj * HALF), b1 = *(const f32x4*)(base + off + bj * HALF + 4);
                    const f32x4 v0 = b0 + acc[ai][bj][m][0] * scale, v1 = b1 + acc[ai][bj][m][1] * scale;
                    *(f32x4*)(out + off + bj * HALF) = v0; *(f32x4*)(out + off + bj * HALF + 4) = v1;
                    s += (v0[0] * v0[0] + v0[1] * v0[1]) + (v0[2] * v0[2] + v0[3] * v0[3]) + (v1[0] * v1[0] + v1[1] * v1[1]) + (v1[2] * v1[2] + v1[3] * v1[3]);
                    if (xb) { u32x4 w; w.x = cvt_pk_bf16(v0[0], v0[1]); w.y = cvt_pk_bf16(v0[2], v0[3]); w.z = cvt_pk_bf16(v1[0], v1[1]); w.w = cvt_pk_bf16(v1[2], v1[3]); *(u32x4*)(xb + off + bj * HALF) = w; } }
                s += __shfl_xor(s, 16); s += __shfl_xor(s, 32);
                if (fq == 0) P[rl * 4 + wc] = s;
                if (m & 1) asm volatile("" ::: "memory"); }
        asm volatile("s_waitcnt lgkmcnt(0)" ::: "memory"); __builtin_amdgcn_s_barrier(); asm volatile("" ::: "memory");
        const int t = wid * 64 + lane;
        if (t < 256) { const PG8_LAS f32x4* P4 = (const PG8_LAS f32x4*)lds; const f32x4 p = P4[t]; ssq[(size_t)(u.pm * BM + t) * 4 + u.pn] = (p[0] + p[1]) + (p[2] + p[3]); }
    }
};

template <class Epi, class Sched, bool ALIGN_EPI = false, bool SP2 = false>
__device__ __forceinline__ void gemm_phase(PG8_LAS unsigned char* lds, const Gemm g, const Sched& S, const Epi& E) {
    const int tid = opaque_tid(), wid = __builtin_amdgcn_readfirstlane(tid >> 6), lane = tid & 63, wr = wid >> 2, wc = wid & 3, fr = lane & 15, fq = lane >> 4;
    const int K = g.K, nt = K / BK;
    static_assert(SP2 || Epi::MIDK == 0, "mid-K hook only in the SP2 loop");
    unsigned voffA[2], voffB[2];
#pragma unroll
    for (int i = 0; i < 2; ++i) { int R, C; stage_rc(tid * 16 + i * 8192, R, C); const int Rb = Epi::PERM ? ((R & ~31) + perm32(R & 31)) : R;
        voffA[i] = (unsigned)(R * K + C) * 2u; voffB[i] = (unsigned)(Rb * K + C) * 2u; }
    const size_t kstep = (size_t)(BK * 2);
    const size_t hstep = (size_t)HALF * K * 2;
    const size_t tstep = 2 * hstep;
    const unsigned ldsw = (unsigned)wid * 1024u;
    const int aoff = lds_byte(wr * 64 + fr, fq * 8), boff = lds_byte(wc * 32 + fr, fq * 8);
#define PG8_SA(b, h) (((b) * 2 + (h)) * HTB)
#define PG8_SB(b, h) ((4 + (b) * 2 + (h)) * HTB)
#define PG8_STAGE(bufoff, gbase, voff) do { _Pragma("unroll") for (int _i = 0; _i < 2; ++_i) \
        __builtin_amdgcn_global_load_lds((const unsigned*)((const char*)(gbase) + (voff)[_i]), (PG8_LAS unsigned*)(lds + (bufoff) + ldsw + _i * 8192), 16, 0, 0); } while (0)
#define PG8_LDA(dst, b, h) do { _Pragma("unroll") for (int m = 0; m < 4; ++m) _Pragma("unroll") for (int k = 0; k < 2; ++k) dst[m][k] = *(const PG8_LAS bf16x8*)(lds + PG8_SA(b, h) + aoff + m * 2048 + k * 1024); } while (0)
#define PG8_LDB(dst, b, h) do { _Pragma("unroll") for (int n = 0; n < 2; ++n) _Pragma("unroll") for (int k = 0; k < 2; ++k) dst[n][k] = *(const PG8_LAS bf16x8*)(lds + PG8_SB(b, h) + boff + n * 2048 + k * 1024); } while (0)
#define PG8_MMA(ai, bj, At, Bt) do { __builtin_amdgcn_s_setprio(1); _Pragma("unroll") for (int m = 0; m < 4; ++m) _Pragma("unroll") for (int n = 0; n < 2; ++n) _Pragma("unroll") for (int k = 0; k < 2; ++k) \
        acc[ai][bj][m][n] = __builtin_amdgcn_mfma_f32_16x16x32_bf16(Bt[n][k], At[m][k], acc[ai][bj][m][n], 0, 0, 0); __builtin_amdgcn_s_setprio(0); } while (0)
#define PG8_WAIT_V(n) asm volatile("s_waitcnt vmcnt(" #n ")" ::: "memory")
#define PG8_WAIT_L(n) asm volatile("s_waitcnt lgkmcnt(" #n ")" ::: "memory")
#define PG8_BAR __builtin_amdgcn_s_barrier()
#define PG8_SCHED __builtin_amdgcn_sched_barrier(0)
    Unit cur, nxt; int ui = 0;
    if (!S.next(0, cur)) return;
    f32x4 acc[2][2][4][2];
#pragma unroll
    for (int a = 0; a < 2; ++a)
#pragma unroll
        for (int b = 0; b < 2; ++b)
#pragma unroll
            for (int m = 0; m < 4; ++m)
#pragma unroll
                for (int n = 0; n < 2; ++n) acc[a][b][m][n] = (f32x4){0.f, 0.f, 0.f, 0.f};
    bf16x8 At[4][2], B0[2][2], B1[2][2];
    const char* cA = (const char*)g.A + (size_t)cur.pm * tstep; const char* cB = (const char*)g.Bt + (size_t)cur.pn * tstep;
    S.a_ready(cur);
    if constexpr (SP2) {
        PG8_STAGE(PG8_SB(0, 0), cB, voffB); PG8_STAGE(PG8_SB(0, 1), cB + hstep, voffB); PG8_STAGE(PG8_SA(0, 0), cA, voffA); PG8_STAGE(PG8_SA(0, 1), cA + hstep, voffA);
        if (wr == 1) PG8_BAR;
        PG8_WAIT_V(2); PG8_BAR;
        PG8_STAGE(PG8_SB(1, 0), cB + kstep, voffB); PG8_STAGE(PG8_SA(1, 0), cA + kstep, voffA); PG8_STAGE(PG8_SB(1, 1), cB + hstep + kstep, voffB);
        PG8_WAIT_V(6); PG8_BAR;
    } else {
        PG8_STAGE(PG8_SB(0, 0), cB, voffB); PG8_STAGE(PG8_SA(0, 0), cA, voffA); PG8_STAGE(PG8_SB(0, 1), cB + hstep, voffB); PG8_STAGE(PG8_SA(0, 1), cA + hstep, voffA);
        if (wr == 1) PG8_BAR;
        PG8_WAIT_V(4); PG8_BAR;
        PG8_STAGE(PG8_SB(1, 0), cB + kstep, voffB); PG8_STAGE(PG8_SA(1, 0), cA + kstep, voffA); PG8_STAGE(PG8_SB(1, 1), cB + hstep + kstep, voffB);
        PG8_WAIT_V(6); PG8_BAR;
    }
    for (;;) {
        const bool has_next = S.next(ui + 1, nxt);
        const char* nA = has_next ? (const char*)g.A + (size_t)nxt.pm * tstep : cA; const char* nB = has_next ? (const char*)g.Bt + (size_t)nxt.pn * tstep : cB;
        for (int t = 0; t < nt; t += 2) {
            const bool last = (t == nt - 2);
            const char* a1 = cA + (size_t)(t + 1) * kstep;
            const char* a2 = last ? nA : cA + (size_t)(t + 2) * kstep; const char* b2 = last ? nB : cB + (size_t)(t + 2) * kstep;
            const char* a3 = a2 + kstep; const char* b3 = b2 + kstep;
            if (last && has_next) S.a_ready(nxt);
            if constexpr (SP2) {
            PG8_LDB(B0, 0, 0); PG8_LDB(B1, 0, 1); PG8_SCHED; PG8_LDA(At, 0, 0); PG8_STAGE(PG8_SA(1, 1), a1 + hstep, voffA);
            PG8_WAIT_V(8); PG8_WAIT_L(0); PG8_BAR; PG8_MMA(0, 0, At, B0); PG8_MMA(0, 1, At, B1); PG8_BAR; PG8_SCHED;
            PG8_LDA(At, 0, 1); PG8_STAGE(PG8_SB(0, 0), b2, voffB); PG8_STAGE(PG8_SB(0, 1), b2 + hstep, voffB); PG8_STAGE(PG8_SA(0, 0), a2, voffA);
            PG8_WAIT_V(8); PG8_WAIT_L(0); PG8_BAR; PG8_MMA(1, 0, At, B0); PG8_MMA(1, 1, At, B1); PG8_BAR; PG8_SCHED;
            PG8_LDB(B0, 1, 0); PG8_LDB(B1, 1, 1); PG8_SCHED; PG8_LDA(At, 1, 0); PG8_STAGE(PG8_SA(0, 1), a2 + hstep, voffA);
            PG8_WAIT_V(8); PG8_WAIT_L(0); PG8_BAR; PG8_MMA(0, 0, At, B0); PG8_MMA(0, 1, At, B1); PG8_BAR; PG8_SCHED;
            PG8_LDA(At, 1, 1); PG8_STAGE(PG8_SB(1, 0), b3, voffB); PG8_STAGE(PG8_SB(1, 1), b3 + hstep, voffB); PG8_STAGE(PG8_SA(1, 0), a3, voffA);
            PG8_WAIT_V(8); PG8_WAIT_L(0); PG8_BAR; PG8_MMA(1, 0, At, B0); PG8_MMA(1, 1, At, B1); PG8_BAR; PG8_SCHED;
            if constexpr (Epi::MIDK > 0) { if (t + 2 == Epi::MIDK) { E.midk(acc, wr, fr, lds); PG8_SCHED; } }
            } else {
            PG8_LDB(B0, 0, 0); PG8_SCHED; PG8_LDA(At, 0, 0); PG8_STAGE(PG8_SA(1, 1), a1 + hstep, voffA);
            PG8_WAIT_L(8); PG8_BAR; PG8_WAIT_L(0); PG8_MMA(0, 0, At, B0); PG8_BAR; PG8_SCHED;
            PG8_LDB(B1, 0, 1); PG8_STAGE(PG8_SB(0, 0), b2, voffB);
            PG8_BAR; PG8_WAIT_L(0); PG8_MMA(0, 1, At, B1); PG8_BAR;
            PG8_LDA(At, 0, 1); PG8_STAGE(PG8_SA(0, 0), a2, voffA);
            PG8_BAR; PG8_WAIT_L(0); PG8_MMA(1, 0, At, B0); PG8_BAR; PG8_SCHED;
            PG8_STAGE(PG8_SB(0, 1), b2 + hstep, voffB);
            PG8_WAIT_V(6); PG8_BAR; PG8_MMA(1, 1, At, B1); PG8_BAR;
            PG8_LDB(B0, 1, 0); PG8_SCHED; PG8_LDA(At, 1, 0); PG8_STAGE(PG8_SA(0, 1), a2 + hstep, voffA);
            PG8_WAIT_L(8); PG8_BAR; PG8_WAIT_L(0); PG8_MMA(0, 0, At, B0); PG8_BAR; PG8_SCHED;
            PG8_LDB(B1, 1, 1); PG8_STAGE(PG8_SB(1, 0), b3, voffB);
            PG8_BAR; PG8_WAIT_L(0); PG8_MMA(0, 1, At, B1); PG8_BAR;
            PG8_LDA(At, 1, 1); PG8_STAGE(PG8_SA(1, 0), a3, voffA);
            PG8_BAR; PG8_WAIT_L(0); PG8_MMA(1, 0, At, B0); PG8_BAR; PG8_SCHED;
            PG8_STAGE(PG8_SB(1, 1), b3 + hstep, voffB);
            PG8_WAIT_V(6); PG8_BAR; PG8_MMA(1, 1, At, B1); PG8_BAR;
            }
        }
        if constexpr (ALIGN_EPI) { if (wr == 0) PG8_BAR; }
        if constexpr (!Epi::AFTER_DRAIN) { E(acc, cur, wr, wc, fr, fq); S.done(cur); }
        if (!has_next) break;
#pragma unroll
        for (int a = 0; a < 2; ++a)
#pragma unroll
            for (int b = 0; b < 2; ++b)
#pragma unroll
                for (int m = 0; m < 4; ++m)
#pragma unroll
                    for (int n = 0; n < 2; ++n) acc[a][b][m][n] = (f32x4){0.f, 0.f, 0.f, 0.f};
        cur = nxt; cA = nA; cB = nB; ++ui;
        if constexpr (ALIGN_EPI) { if (wr == 1) PG8_BAR; }
    }
    PG8_WAIT_V(0);
    if constexpr (!ALIGN_EPI) { if (wr == 0) PG8_BAR; }
    PG8_BAR;
    if constexpr (Epi::AFTER_DRAIN) { E.fused(acc, cur, wr, wc, fr, fq, lds, wid, lane); S.done(cur); }
#undef PG8_SA
#undef PG8_SB
#undef PG8_STAGE
#undef PG8_LDA
#undef PG8_LDB
#undef PG8_MMA
#undef PG8_WAIT_V
#undef PG8_WAIT_L
#undef PG8_BAR
#undef PG8_SCHED
}
}

#include <hip/hip_bf16.h>
#include <cmath>
namespace attn_body {
using bf16=__hip_bfloat16;
using bf16x8=__attribute__((ext_vector_type(8)))short;
using s16x4=__attribute__((ext_vector_type(4)))short;
using f32x16=__attribute__((ext_vector_type(16)))float;
using u32x4=__attribute__((ext_vector_type(4)))unsigned;
using f32x4_t=__attribute__((ext_vector_type(4)))float;
constexpr int BATCH=8,NHEAD=8,SEQ=2048,D=64,DM=1024;
constexpr int NW=8,QBLK=32,QB=QBLK*NW,KVBLK=64,NQB=SEQ/QB;
constexpr int ATTN_PITCH=DM, ATTN_UNIT_ROWS=QB;
__device__ __forceinline__ int crow(int r,int hi){return (r&3)+8*(r>>2)+4*hi;}
#define SBAR() __builtin_amdgcn_sched_barrier(0)
__device__ __forceinline__ void cmask(f32x16&p0,f32x16&p1,int jb,int qrel,int hi){
  const float NEG=-INFINITY; int kb=64*jb+4*hi;
  #pragma unroll
  for(int r=0;r<16;++r){int kv=kb+(r&3)+8*(r>>2); if(kv>qrel)p0[r]=NEG; if(kv+32>qrel)p1[r]=NEG;}
}

constexpr int NSLOT=3, SLOTB=8192;
constexpr int LDS_K=0, LDS_V=NSLOT*SLOTB, LDS_WS=2*NSLOT*SLOTB, LDS_OST=LDS_WS+NW*64*4, LDS_DL=LDS_OST+NW*4096, LDS_WT=LDS_DL+SEQ*4, LDS_BYTES=LDS_WT+64;
constexpr float C2=0.125f*1.4426950408889634f;
__device__ __forceinline__ void glds16(const void*gsrc,unsigned lds_dst){unsigned keep;
  asm volatile("s_mov_b32 %0, m0\n\ts_mov_b32 m0, %2\n\ts_nop 0\n\tglobal_load_lds_dwordx4 %1, off\n\ts_mov_b32 m0, %0":"=&s"(keep):"v"(gsrc),"s"(lds_dst):"memory");}
__device__ __forceinline__ float max3f(float a,float b,float c){float r;asm("v_max3_f32 %0, %1, %2, %3":"=v"(r):"v"(a),"v"(b),"v"(c));return r;}
__device__ __forceinline__ float max2f(float a,float b){float r;asm("v_max_f32_e32 %0, %1, %2":"=v"(r):"v"(a),"v"(b));return r;}
__device__ __forceinline__ float fadd_s(float a,float b){float r;asm("v_add_f32_e32 %0, %1, %2":"=v"(r):"v"(a),"v"(b));return r;}
__device__ __forceinline__ float fsub_s(float a,float b){float r;asm("v_sub_f32_e32 %0, %1, %2":"=v"(r):"v"(a),"v"(b));return r;}
typedef float f32x2_t __attribute__((ext_vector_type(2))); typedef __bf16 bf16x2_t __attribute__((ext_vector_type(2)));
__device__ __forceinline__ unsigned cvtpk_s(float lo,float hi){f32x2_t v={lo,hi};bf16x2_t b=__builtin_convertvector(v,bf16x2_t);return __builtin_bit_cast(unsigned,b);}
#define WAIT_BAR(N) asm volatile("s_waitcnt vmcnt(" #N ") lgkmcnt(0)\n\ts_barrier":::"memory")

__device__ __forceinline__ void qkt(f32x16&p0,f32x16&p1,const char*Kslot,const bf16x8*qr,int r32,int hi){
  const char*kb=Kslot+hi*1024+r32*16;
  #pragma unroll
  for(int d0=0;d0<4;++d0){
    const bf16x8 b0=*reinterpret_cast<const bf16x8*>(kb+d0*2048);
    const bf16x8 b1=*reinterpret_cast<const bf16x8*>(kb+d0*2048+512);
    p0=__builtin_amdgcn_mfma_f32_32x32x16_bf16(b0,qr[d0],p0,0,0,0);p1=__builtin_amdgcn_mfma_f32_32x32x16_bf16(b1,qr[d0],p1,0,0,0);}
}
typedef __attribute__((address_space(3))) const char* lds_cptr;
typedef short v4i16_t __attribute__((ext_vector_type(4)));
__device__ __forceinline__ void kload8(bf16x8*kf,lds_cptr kp){
  kf[0]=*(const __attribute__((address_space(3))) bf16x8*)(kp);      kf[1]=*(const __attribute__((address_space(3))) bf16x8*)(kp+512);
  kf[2]=*(const __attribute__((address_space(3))) bf16x8*)(kp+2048); kf[3]=*(const __attribute__((address_space(3))) bf16x8*)(kp+2560);
  kf[4]=*(const __attribute__((address_space(3))) bf16x8*)(kp+4096); kf[5]=*(const __attribute__((address_space(3))) bf16x8*)(kp+4608);
  kf[6]=*(const __attribute__((address_space(3))) bf16x8*)(kp+6144); kf[7]=*(const __attribute__((address_space(3))) bf16x8*)(kp+6656);
}
__device__ __forceinline__ void kload2(bf16x8*kf,lds_cptr kp,int j){ kf[2*j]=*(const __attribute__((address_space(3))) bf16x8*)(kp+j*2048); kf[2*j+1]=*(const __attribute__((address_space(3))) bf16x8*)(kp+j*2048+512); }
__device__ __forceinline__ s16x4 vtr(lds_cptr p){ return __builtin_bit_cast(s16x4,__builtin_amdgcn_ds_read_tr16_b64_v4i16((__attribute__((address_space(3))) v4i16_t*)p)); }
__device__ __forceinline__ float rowmax(const f32x16&p0,const f32x16&p1){
  float a=max3f(p0[0],p0[1],p1[0]),b=max3f(p0[2],p0[3],p1[1]);a=max3f(a,p1[2],p1[3]);
  #pragma unroll
  for(int r=4;r<16;r+=4){a=max3f(a,p0[r],p0[r+1]);b=max3f(b,p0[r+2],p0[r+3]);a=max3f(a,p1[r],p1[r+1]);b=max3f(b,p1[r+2],p1[r+3]);}
  const float m=max2f(a,b);
  auto rr=__builtin_amdgcn_permlane32_swap(__float_as_uint(m),__float_as_uint(m),false,false);
  return max2f(__uint_as_float(rr[0]),__uint_as_float(rr[1]));
}
__device__ __forceinline__ void pv(f32x16*o,int vb,bf16x8 pa0,bf16x8 pa1,bf16x8 pa2,bf16x8 pa3){
  #pragma unroll
  for(int d0=0;d0<2;++d0){s16x4 lo[4],hi[4];
    #pragma unroll
    for(int ks=0;ks<4;++ks){
      asm volatile("ds_read_b64_tr_b16 %0,%1 offset:%c2":"=&v"(lo[ks]):"v"(vb),"i"(d0*4096+ks*1024):"memory");
      asm volatile("ds_read_b64_tr_b16 %0,%1 offset:%c2":"=&v"(hi[ks]):"v"(vb),"i"(d0*4096+ks*1024+512):"memory");}
    asm volatile("s_waitcnt lgkmcnt(0)":::"memory");SBAR();
    #define PK(k) (bf16x8){lo[k][0],lo[k][1],lo[k][2],lo[k][3],hi[k][0],hi[k][1],hi[k][2],hi[k][3]}
    o[d0]=__builtin_amdgcn_mfma_f32_32x32x16_bf16(pa0,PK(0),o[d0],0,0,0);
    o[d0]=__builtin_amdgcn_mfma_f32_32x32x16_bf16(pa1,PK(1),o[d0],0,0,0);
    o[d0]=__builtin_amdgcn_mfma_f32_32x32x16_bf16(pa2,PK(2),o[d0],0,0,0);
    o[d0]=__builtin_amdgcn_mfma_f32_32x32x16_bf16(pa3,PK(3),o[d0],0,0,0);
    #undef PK
  }
}

#ifndef ATTN_STORE16
#define ATTN_STORE16(p,v) (*(u32x4*)(p)=(v))
#endif
template<int THRL> __device__ __forceinline__ void attn_unit(int b,int h,int qb,const bf16*Q,const bf16*__restrict__ K,const bf16*__restrict__ V,bf16*O,const float*LF,float*SSQA,char*shm){
  const int tid=opaque_tid(),lane=tid&63,r32=lane&31,hi=lane>>5; const int wid=__builtin_amdgcn_readfirstlane(tid>>6);
  const long rowbase=(long)b*SEQ; const int q0=qb*QB;
  const bf16*Qw=Q+(rowbase+q0+wid*QBLK)*DM+h*D;
  const bf16*Kh=K+rowbase*DM+h*D,*Vh=V+rowbase*DM+h*D;
  const unsigned lds0=(unsigned)(uintptr_t)shm;
  float*wsf=(float*)(shm+LDS_WS)+wid*64;
  const bf16*ksrc=Kh+(long)lane*DM+wid*8;
  const bf16*vsrc=Vh+(long)(16*(wid&3)+(lane>>2))*DM+(wid>>2)*32+(lane&3)*8;
  const unsigned kdst=lds0+LDS_K+wid*1024, vdst=lds0+LDS_V+wid*1024;
  #define DMA_K(t,slot) glds16(ksrc+(long)(t)*KVBLK*DM,(unsigned)__builtin_amdgcn_readfirstlane(kdst+(slot)))
  #define DMA_V(t,slot) glds16(vsrc+(long)(t)*KVBLK*DM,(unsigned)__builtin_amdgcn_readfirstlane(vdst+(slot)))
  const int vb0=(int)(lds0+LDS_V)+((lane>>4)&1)*32+(lane&3)*8+(4*hi+((lane&15)>>2))*64;
  const char*Kbase=shm+LDS_K; bf16x8 kf[8];
  const lds_cptr shm3=(lds_cptr)shm; const lds_cptr kp0=shm3+LDS_K+hi*1024+r32*16; const lds_cptr vp0=shm3+LDS_V+((lane>>4)&1)*32+(lane&3)*8+(4*hi+((lane&15)>>2))*64;
  const int NT=(q0+QB)/KVBLK;
  DMA_K(0,0);DMA_V(0,0);DMA_K(1,SLOTB);
  bf16x8 qr[4];
  #pragma unroll
  for(int d0=0;d0<4;++d0)qr[d0]=*reinterpret_cast<const bf16x8*>(&Qw[(long)r32*DM+d0*16+hi*8]);
  float l_reg=0.f;f32x16 o[2];o[0]=f32x16{};o[1]=f32x16{};
  const int qrel=wid*QBLK+r32;
  #define CMASK(P0,P1,t) do{int jb_=(t)-(NT-4); if(jb_>=0)cmask(P0,P1,jb_,qrel,hi);}while(0)
  bool resc=false;
  #define START(P0,P1) do{ const float rm=rowmax(P0,P1); resc=false; \
    { const float dl=rm; nbq=fsub_s(nbq,dl); \
      _Pragma("unroll") for(int r=0;r<16;++r){P0[r]=fsub_s(P0[r],dl);P1[r]=fsub_s(P1[r],dl);} } \
    _Pragma("unroll") for(int r=0;r<16;++r)P0[r]=__builtin_amdgcn_exp2f(P0[r]); }while(0)
  #define RESC() do{ if(resc){ asm volatile("s_waitcnt lgkmcnt(0)":::"memory"); \
      _Pragma("unroll") for(int d_=0;d_<2;++d_) _Pragma("unroll") for(int r=0;r<16;++r)o[d_][r]*=wsf[crow(r,hi)]; } }while(0)
  f32x16 pA0,pA1,pB0,pB1;
  int sl_prev=0,sl_cur=0,sl_next=SLOTB;
  #define ROT() do{sl_prev=sl_cur;sl_cur=sl_next;sl_next=(sl_next==(NSLOT-1)*SLOTB)?0:sl_next+SLOTB;}while(0)
  DMA_K(2,2*SLOTB);
  { const int n=q0+QB; const float*lf=LF+(long)(b*NHEAD+h)*SEQ;
    f32x4_t v={0.f,0.f,0.f,0.f}; if(4*tid<n)v=*(const f32x4_t*)(lf+4*tid);
    v[1]+=v[0];v[2]+=v[1];v[3]+=v[2];
    float incl=v[3];
    #pragma unroll
    for(int o_=1;o_<64;o_<<=1){const float u_=__shfl_up(incl,o_);if(lane>=o_)incl+=u_;}
    const float excl=incl-v[3];
    __attribute__((address_space(3))) float*wt=(__attribute__((address_space(3))) float*)(shm+LDS_WT);
    if(lane==63)wt[wid]=incl;
    asm volatile("s_waitcnt lgkmcnt(0)\n\ts_barrier":::"memory");
    float pre=excl;
    #pragma unroll
    for(int w_=0;w_<NW;++w_){const float x_=wt[w_];if(w_<wid)pre+=x_;}
    if(4*tid<n){f32x4_t w4;w4[0]=v[0]+pre;w4[1]=v[1]+pre;w4[2]=v[2]+pre;w4[3]=v[3]+pre;*(__attribute__((address_space(3))) f32x4_t*)(shm+LDS_DL+16*tid)=w4;}
    asm volatile("s_waitcnt lgkmcnt(0)\n\ts_barrier":::"memory"); }
  const __attribute__((address_space(3))) char*dl0=(const __attribute__((address_space(3))) char*)(shm+LDS_DL)+hi*16;
  float nbq=((const __attribute__((address_space(3))) float*)(shm+LDS_DL))[q0+wid*QBLK+r32];
  #define BIAS(C0,C1,t) do{ const __attribute__((address_space(3))) f32x4_t*dp_=(const __attribute__((address_space(3))) f32x4_t*)(dl0+(t)*256); \
    _Pragma("unroll") for(int j_=0;j_<4;++j_){ const f32x4_t a_=dp_[2*j_],b_=dp_[2*j_+8]; \
      _Pragma("unroll") for(int i_=0;i_<4;++i_){C0[4*j_+i_]=nbq-a_[i_];C1[4*j_+i_]=nbq-b_[i_];} } }while(0)
  WAIT_BAR(3);
  BIAS(pA0,pA1,0);
  qkt(pA0,pA1,Kbase,qr,r32,hi);asm volatile("s_nop 15\n\ts_nop 7":"+v"(pA0),"+v"(pA1));CMASK(pA0,pA1,0);
  START(pA0,pA1);
  _Pragma("unroll") for(int r=0;r<16;++r)pA1[r]=__builtin_amdgcn_exp2f(pA1[r]);
  WAIT_BAR(0);
  DMA_K(3,0);DMA_V(1,SLOTB);
  ROT();
  kload8(kf,kp0+sl_cur);
  WAIT_BAR(2);
  s16x4 vlo[8],vhi[8]; u32x4 pw0,pw1,pw2,pw3;
  #define PKW(P,B) cvtpk_s(P[B],P[B+1])
  #define PAF(k) __builtin_bit_cast(bf16x8,pw##k)
  #define VFR(i) (bf16x8){vlo[i][0],vlo[i][1],vlo[i][2],vlo[i][3],vhi[i][0],vhi[i][1],vhi[i][2],vhi[i][3]}
  #define PIN(x) asm volatile("":"+v"(x))
  #define MX3(a,b,c) __builtin_fmaxf(__builtin_fmaxf((a),(b)),(c))
  #define GAPA(MF,A0,A1,A2,A3,W0,W1,PW) do{ MF; sacc+=A0; sacc+=A1; sacc+=A2; sacc+=A3; PIN(sacc); W0; W1; PIN(PW); SBAR(); }while(0)
  #define EX(v) __builtin_amdgcn_exp2f(v)
  #define GAPB(MF,X,B) do{ MF; X[B]=EX(X[B]); X[B+1]=EX(X[B+1]); X[B+2]=EX(X[B+2]); X[B+3]=EX(X[B+3]); PIN(X); SBAR(); }while(0)
  #define VRD(i) do{ vlo[i]=vtr(vp_+(((i)>>2)*4096+((i)&3)*1024)); vhi[i]=vtr(vp_+(((i)>>2)*4096+((i)&3)*1024+512)); }while(0)
  #define KRD(G,j) do{ if(G){ kload2(kf,kp0+sl_next,j); SBAR(); } }while(0)
  #define STEP(C0,C1,P0,P1,t,GK,GV,GL) do{ SBAR(); \
    const lds_cptr vp_=vp0+sl_prev; BIAS(C0,C1,t); \
    VRD(0); SBAR(); float sacc=(P0[0]+P0[1]); \
    GAPA(C0=__builtin_amdgcn_mfma_f32_32x32x16_bf16(kf[0],qr[0],C0,0,0,0), P0[2],P0[3],P0[4],P0[5],     pw0[0]=PKW(P0,0), pw0[1]=PKW(P0,2), pw0); \
    VRD(4); SBAR(); GAPA(C1=__builtin_amdgcn_mfma_f32_32x32x16_bf16(kf[1],qr[0],C1,0,0,0), P0[6],P0[7],P0[8],P0[9],     pw0[2]=PKW(P0,4), pw0[3]=PKW(P0,6), pw0); \
    VRD(1); SBAR(); GAPA(C0=__builtin_amdgcn_mfma_f32_32x32x16_bf16(kf[2],qr[1],C0,0,0,0),   P0[10],P0[11],P0[12],P0[13], pw1[0]=PKW(P0,8), pw1[1]=PKW(P0,10), pw1); \
    VRD(5); SBAR(); GAPA(C1=__builtin_amdgcn_mfma_f32_32x32x16_bf16(kf[3],qr[1],C1,0,0,0),   P0[14],P0[15],P1[0],P1[1],   pw1[2]=PKW(P0,12),pw1[3]=PKW(P0,14), pw1); \
    VRD(2); SBAR(); GAPA(C0=__builtin_amdgcn_mfma_f32_32x32x16_bf16(kf[4],qr[2],C0,0,0,0),   P1[2],P1[3],P1[4],P1[5],     pw2[0]=PKW(P1,0), pw2[1]=PKW(P1,2), pw2); \
    VRD(6); SBAR(); GAPA(C1=__builtin_amdgcn_mfma_f32_32x32x16_bf16(kf[5],qr[2],C1,0,0,0),   P1[6],P1[7],P1[8],P1[9],     pw2[2]=PKW(P1,4), pw2[3]=PKW(P1,6), pw2); \
    VRD(3); SBAR(); GAPA(C0=__builtin_amdgcn_mfma_f32_32x32x16_bf16(kf[6],qr[3],C0,0,0,0),   P1[10],P1[11],P1[12],P1[13], pw3[0]=PKW(P1,8), pw3[1]=PKW(P1,10), pw3); \
    VRD(7); SBAR(); GAPA(C1=__builtin_amdgcn_mfma_f32_32x32x16_bf16(kf[7],qr[3],C1,0,0,0),   P1[14],P1[15],0.f,0.f,       pw3[2]=PKW(P1,12),pw3[3]=PKW(P1,14), pw3); \
    l_reg+=sacc; \
    if(GK){DMA_K((t)+3,sl_cur);} if(GV){DMA_V((t)+1,sl_next);} \
    CMASK(C0,C1,t); \
    { float a=MX3(C0[0],C0[1],C1[0]),b=MX3(C0[2],C0[3],C1[1]); a=MX3(a,C1[2],C1[3]); \
      _Pragma("unroll") for(int r=4;r<16;r+=4){a=MX3(a,C0[r],C0[r+1]);b=MX3(b,C0[r+2],C0[r+3]);a=MX3(a,C1[r],C1[r+1]);b=MX3(b,C1[r+2],C1[r+3]);} \
      float rm=__builtin_fmaxf(a,b); { auto rr=__builtin_amdgcn_permlane32_swap(__float_as_uint(rm),__float_as_uint(rm),false,false); rm=__builtin_fmaxf(__uint_as_float(rr[0]),__uint_as_float(rr[1])); } \
      resc=false; \
      if(__any(rm>(float)THRL)){ const float dl=__builtin_fmaxf(rm,0.f); nbq-=dl; \
        _Pragma("unroll") for(int r=0;r<16;++r){C0[r]-=dl;C1[r]-=dl;} \
        const float f=__builtin_amdgcn_exp2f(-dl); l_reg*=f; if(hi==0)wsf[r32]=f; resc=true; } } \
    SBAR(); \
    GAPB(o[0]=__builtin_amdgcn_mfma_f32_32x32x16_bf16(PAF(0),VFR(0),o[0],0,0,0), C0,0); \
    GAPB(o[1]=__builtin_amdgcn_mfma_f32_32x32x16_bf16(PAF(0),VFR(4),o[1],0,0,0), C0,4); \
    KRD(GL,0); GAPB(o[0]=__builtin_amdgcn_mfma_f32_32x32x16_bf16(PAF(1),VFR(1),o[0],0,0,0), C0,8); \
    KRD(GL,1); GAPB(o[1]=__builtin_amdgcn_mfma_f32_32x32x16_bf16(PAF(1),VFR(5),o[1],0,0,0), C0,12); \
    KRD(GL,2); GAPB(o[0]=__builtin_amdgcn_mfma_f32_32x32x16_bf16(PAF(2),VFR(2),o[0],0,0,0), C1,0); \
    KRD(GL,3); GAPB(o[1]=__builtin_amdgcn_mfma_f32_32x32x16_bf16(PAF(2),VFR(6),o[1],0,0,0), C1,4); \
    GAPB(o[0]=__builtin_amdgcn_mfma_f32_32x32x16_bf16(PAF(3),VFR(3),o[0],0,0,0), C1,8); \
    GAPB(o[1]=__builtin_amdgcn_mfma_f32_32x32x16_bf16(PAF(3),VFR(7),o[1],0,0,0), C1,12); \
    }while(0)
  int t=1;
  #undef CMASK
  #define CMASK(P0,P1,t) do{}while(0)
  for(;t+5<NT;t+=2){
    STEP(pB0,pB1,pA0,pA1,t,true,true,true);     WAIT_BAR(2); RESC(); ROT();
    STEP(pA0,pA1,pB0,pB1,t+1,true,true,true);   WAIT_BAR(2); RESC(); ROT();
  }
  #undef CMASK
  #define CMASK(P0,P1,t) do{int jb_=(t)-(NT-4); if(jb_>=0)cmask(P0,P1,jb_,qrel,hi);}while(0)
  #define ENDW(tt) do{ if((tt)+3<NT){WAIT_BAR(2);} else if((tt)+2<NT){WAIT_BAR(1);} else {WAIT_BAR(0);} }while(0)
  for(;t+1<NT;t+=2){
    STEP(pB0,pB1,pA0,pA1,t,(t+3<NT),(t+1<NT),(t+1<NT));       ENDW(t);   RESC(); ROT();
    STEP(pA0,pA1,pB0,pB1,t+1,(t+4<NT),(t+2<NT),(t+2<NT));     ENDW(t+1); RESC(); ROT();
  }
  STEP(pB0,pB1,pA0,pA1,NT-1,false,false,false); RESC();
  { float sacc=pB0[0]+pB0[1]; _Pragma("unroll") for(int r=2;r<16;++r)sacc+=pB0[r]; _Pragma("unroll") for(int r=0;r<16;++r)sacc+=pB1[r]; l_reg+=sacc;
    pw0=(u32x4){PKW(pB0,0),PKW(pB0,2),PKW(pB0,4),PKW(pB0,6)};pw1=(u32x4){PKW(pB0,8),PKW(pB0,10),PKW(pB0,12),PKW(pB0,14)};pw2=(u32x4){PKW(pB1,0),PKW(pB1,2),PKW(pB1,4),PKW(pB1,6)};pw3=(u32x4){PKW(pB1,8),PKW(pB1,10),PKW(pB1,12),PKW(pB1,14)};
    SBAR(); pv(o,vb0+sl_cur,PAF(0),PAF(1),PAF(2),PAF(3)); }
  #undef PKW
  #undef PAF
  #undef VFR
  #undef PIN
  #undef MX3
  #undef GAPA
  #undef GAPB
  #undef EX
  #undef VRD
  #undef KRD
  #undef STEP
  #undef ENDW
  {auto rr=__builtin_amdgcn_permlane32_swap(__float_as_uint(l_reg),__float_as_uint(l_reg),false,false);l_reg=__uint_as_float(rr[0])+__uint_as_float(rr[1]);}
  if(hi==0)wsf[32+r32]=l_reg;asm volatile("s_waitcnt lgkmcnt(0)":::"memory");
  float rli[16];
  #pragma unroll
  for(int r=0;r<16;++r)rli[r]=__builtin_amdgcn_rcpf(wsf[32+crow(r,hi)]);
  bf16*Ow=O+(rowbase+q0+wid*QBLK)*DM+h*D;
  { bf16*stg=(bf16*)(shm+LDS_OST)+wid*2048;
    #pragma unroll
    for(int r=0;r<16;++r){const int orow=crow(r,hi);
      #pragma unroll
      for(int d0=0;d0<2;++d0)stg[orow*64+d0*32+r32]=__float2bfloat16(o[d0][r]*rli[r]);}
    asm volatile("s_waitcnt lgkmcnt(0)":::"memory");
    #pragma unroll
    for(int i=0;i<4;++i){const int row=i*8+(lane>>3),ch=lane&7; const u32x4 v=*(const u32x4*)(stg+row*64+ch*8); ATTN_STORE16(Ow+(long)row*DM+ch*8,v);
      float s_=0.f;
      #pragma unroll
      for(int e_=0;e_<4;++e_){const float lo_=__uint_as_float(v[e_]<<16),hi_=__uint_as_float(v[e_]&0xffff0000u);s_+=lo_*lo_+hi_*hi_;}
      s_+=__shfl_xor(s_,1);s_+=__shfl_xor(s_,2);s_+=__shfl_xor(s_,4);
      if(ch==0)SSQA[(rowbase+q0+wid*QBLK+row)*NHEAD+h]=s_;} }
  asm volatile("s_waitcnt lgkmcnt(0)\n\ts_barrier":::"memory");
  #undef DMA_K
  #undef DMA_V
  #undef CMASK
  #undef START
  #undef RESC
  #undef ROT
  #undef BIAS
}
constexpr int ATTN_LDS_BYTES=LDS_BYTES;
struct AttnTensors { const bf16* Q; const bf16* K; const bf16* V; bf16* O; const float* LF; float* SSQA; };
struct AttnUnit { int bh; int qb; };
struct StaticOrder {
  int vcu;
  __device__ __forceinline__ explicit StaticOrder(int grid,int block):vcu((block%8)*(grid/8)+block/8){}
  __device__ __forceinline__ bool next(int i,AttnUnit&u)const{ if(i>=2)return false; const int s=vcu&3; u.bh=vcu>>2; u.qb=(i==0)?7-s:s; return true; }
  __device__ __forceinline__ void a_ready(const AttnUnit&)const{}
  __device__ __forceinline__ void done(const AttnUnit&)const{}
};
template<class Sched,int THRL=8> __device__ __forceinline__ void attn_phase(char*lds,const AttnTensors&T,const Sched&S){
  AttnUnit u;
  for(int i=0;S.next(i,u);++i){ S.a_ready(u); attn_unit<THRL>(u.bh/NHEAD,u.bh%NHEAD,u.qb,T.Q,T.K,T.V,T.O,T.LF,T.SSQA,lds); S.done(u); }
}
#undef SBAR
#undef WAIT_BAR
}

constexpr int NWAVES = 8;

constexpr int BATCH = 8, SEQ = 2048, D = 1024, NH = 8, HD = 64, DFF = 2816, DCONV = 512, DATTN = 512, CONVW = 31, NIN = 2568, NINP = 2816;
constexpr int M = BATCH * SEQ;
constexpr float EPS = 1e-6f;
static_assert(DFF == FF_DIM, "act pitch");

constexpr size_t MiB = 1u << 20;
constexpr size_t WS_CTL = 0, CTL_ZERO_BYTES = 1 * MiB;
constexpr size_t WS_W13A = 2 * MiB, WS_W2A = 13 * MiB, WS_WIN = 19 * MiB, WS_WOUT = 25 * MiB, WS_W13B = 27 * MiB, WS_W2B = 38 * MiB;
constexpr size_t WS_LF = 45 * MiB;
constexpr size_t WS_RS0 = 46 * MiB;
constexpr size_t WS_SSQ1 = WS_RS0 + 256 * 1024, WS_SSQ2 = WS_SSQ1 + 256 * 1024, WS_SSQ3 = WS_SSQ2 + 256 * 1024;
constexpr size_t WS_SSQA = 47 * MiB;
constexpr size_t WS_XB = 48 * MiB;
constexpr size_t WS_ACT = 80 * MiB;
constexpr size_t WS_U = 80 * MiB, WS_KV = 96 * MiB, WS_Y = 128 * MiB;
constexpr size_t WS_END = 168 * MiB;
static_assert(WS_W13A + (size_t)2 * DFF * D * 2 <= WS_W2A && WS_W2A + (size_t)D * DFF * 2 <= WS_WIN && WS_WIN + (size_t)NINP * D * 2 <= WS_WOUT && WS_WOUT + (size_t)D * D * 2 <= WS_W13B &&
              WS_W13B + (size_t)2 * DFF * D * 2 <= WS_W2B && WS_W2B + (size_t)D * DFF * 2 <= WS_LF && WS_LF + (size_t)M * NH * 4 <= WS_RS0 && WS_SSQ3 + 256 * 1024 <= WS_SSQA && WS_SSQA + (size_t)M * NH * 4 <= WS_XB &&
              WS_XB + (size_t)M * D * 2 <= WS_ACT && WS_ACT + (size_t)M * DFF * 2 <= WS_END && WS_Y + (size_t)M * D * 2 <= WS_END && WS_U + (size_t)M * 512 * 2 <= WS_KV && WS_KV + (size_t)M * D * 2 <= WS_Y, "d_ws map");
constexpr int CW_TMO = 0, CW_CODE = 1;
constexpr int CW_BAR = 4096;

constexpr int RING_OFF = 0, RING_BYTES = 131072;
constexpr int LDSCTL_OFF = RING_BYTES, MISC_OFF = LDSCTL_OFF + 320;
constexpr int LDS_BYTES = 147456;
static_assert(MISC_OFF + 128 <= RSC_OFF && RSC_OFF + 1024 <= LDS_BYTES, "LDS map");

#define GAS __attribute__((address_space(1)))
#define LAS __attribute__((address_space(3)))
typedef unsigned short bf16;
typedef unsigned v4u __attribute__((ext_vector_type(4)));
typedef float f32x4 __attribute__((ext_vector_type(4)));
typedef short bf16x8 __attribute__((ext_vector_type(8)));
typedef GAS unsigned gu32;
typedef GAS unsigned long long gu64;
#define RLX_AGENT __ATOMIC_RELAXED, __HIP_MEMORY_SCOPE_AGENT
#define LDS_WAIT() asm volatile("s_waitcnt lgkmcnt(0)" ::: "memory")
#define VM_WAIT() asm volatile("s_waitcnt vmcnt(0)" ::: "memory")
__device__ __forceinline__ unsigned long long rt() { return __builtin_amdgcn_s_memrealtime(); }
__device__ __forceinline__ unsigned f2bf(float f) { unsigned u = __builtin_bit_cast(unsigned, f); return (u + 0x7fffu + ((u >> 16) & 1u)) >> 16; }
__device__ __forceinline__ unsigned pk2(float lo, float hi) { return f2bf(lo) | (f2bf(hi) << 16); }

#define XB_TMO      128
#define XB_XCNT(j)  (256  + 64 * (j))
#define XB_XSUB(j)  (1280 + 64 * (j))
#define XB_XGEN(j)  (2304 + 64 * (j))
#define XB_TOP      3328
#define XB_TOPGEN   3392
#define XCD_BAR_WORDS 3456
#define XB_SPIN_CAP (1u << 18)

__device__ __forceinline__ unsigned xb_ld(unsigned* p)              { return __hip_atomic_load(p, __ATOMIC_RELAXED, __HIP_MEMORY_SCOPE_AGENT); }
__device__ __forceinline__ unsigned xb_add(unsigned* p, unsigned v) { return __hip_atomic_fetch_add(p, v, __ATOMIC_RELAXED, __HIP_MEMORY_SCOPE_AGENT); }
__device__ __forceinline__ unsigned xb_xcc_id() { return (unsigned)__builtin_amdgcn_s_getreg((3 << 11) | 20) & 0xFu; }
#define XB_SPIN(cond, bar) do { unsigned _sp = 0; while (cond) { __builtin_amdgcn_s_sleep(1); \
    if ((++_sp & 255u) == 0u) { if (xb_ld(&(bar)[XB_TMO])) break; if (_sp > XB_SPIN_CAP) { atomicAdd(&(bar)[XB_TMO], 1u); break; } } } } while (0)

struct XcdBarrier {
    unsigned* bar; unsigned x;
    volatile LAS unsigned* st;
};

__device__ __forceinline__ XcdBarrier xcd_barrier_post(unsigned* bar, volatile LAS unsigned* st) {
    XcdBarrier b; b.bar = bar; b.x = xb_xcc_id(); b.st = st;
    if (threadIdx.x == 0) (void)xb_add(&bar[XB_XCNT(b.x)], 1u);
    return b;
}
__device__ __forceinline__ void xcd_barrier_complete(unsigned* bar, unsigned x, unsigned& nloc, unsigned& nx) {
    const unsigned G = gridDim.x * gridDim.y * gridDim.z;
    unsigned sum, cnt, mine, sp = 0u;
    for (;;) {
        sum = 0u; cnt = 0u; mine = 0u;
#pragma unroll
        for (unsigned j = 0; j < 16; ++j) { const unsigned c = xb_ld(&bar[XB_XCNT(j)]); sum += c; cnt += (c > 0u) ? 1u : 0u; mine = (j == x) ? c : mine; }
        if (sum == G) break;
        __builtin_amdgcn_s_sleep(1);
        if ((++sp & 255u) == 0u) { if (xb_ld(&bar[XB_TMO])) break; if (sp > XB_SPIN_CAP) { atomicAdd(&bar[XB_TMO], 1u); break; } }
    }
    nloc = mine > 0u ? mine : 1u; nx = cnt > 0u ? cnt : 1u;
}

__device__ __forceinline__ void xcd_barrier(const XcdBarrier& b) {
    asm volatile("s_waitcnt vmcnt(0)" ::: "memory");
    __syncthreads();
    if (threadIdx.x == 0) {
        unsigned* bar = b.bar;
        __builtin_amdgcn_s_waitcnt(0);
        unsigned nloc = b.st[0], nx = b.st[1];
        if (nloc == 0u) { xcd_barrier_complete(bar, b.x, nloc, nx); b.st[0] = nloc; b.st[1] = nx; }
        const unsigned old = xb_add(&bar[XB_XSUB(b.x)], 1u);
        const unsigned gen = old / nloc;
        if (old + 1u == (gen + 1u) * nloc) {
            __builtin_amdgcn_fence(__ATOMIC_RELEASE, "agent");
            asm volatile("s_waitcnt vmcnt(0)" ::: "memory");
            const unsigned og = xb_add(&bar[XB_TOP], 1u);
            const unsigned tg = og / nx;
            if (og + 1u == (tg + 1u) * nx) xb_add(&bar[XB_TOPGEN], 1u);
            else XB_SPIN(xb_ld(&bar[XB_TOPGEN]) == tg, bar);
            __builtin_amdgcn_fence(__ATOMIC_ACQUIRE, "agent");
            xb_add(&bar[XB_XGEN(b.x)], 1u);
            asm volatile("s_waitcnt vmcnt(0)" ::: "memory");
        } else {
            XB_SPIN(xb_ld(&bar[XB_XGEN(b.x)]) == gen, bar);
            __builtin_amdgcn_fence(__ATOMIC_ACQUIRE, "agent");
            asm volatile("s_waitcnt vmcnt(0)" ::: "memory");
        }
    }
    __syncthreads();
}

struct Frame {
    LAS unsigned char* lds;
    volatile LAS unsigned* MISC;
    gu32* ctl;
    int tid, lane, wave;
    int vcu, G;
    const float* x; float* out;
    const float *g1, *w13a, *w2a, *gmix, *win, *cw, *cb, *lng, *lnb, *fb, *gyc, *gya, *wout, *g2, *w13b, *w2b, *gfin;
    bf16 *W13A, *W2A, *WIN, *WOUT, *W13B, *W2B;
    bf16 *XB, *ACT, *U, *KV, *Y;
    float *LF, *RS0, *SSQ1, *SSQ2, *SSQ3, *SSQA;
};

#define FRAME_REFRESH(F) do { (F).tid = opaque_tid(); (F).lane = (F).tid & 63; (F).wave = __builtin_amdgcn_readfirstlane((F).tid >> 6); } while (0)
__device__ __forceinline__ float wave_sum(float v) {
#pragma unroll
    for (int o = 1; o < 64; o <<= 1) v += __shfl_xor(v, o);
    return v;
}
__device__ __forceinline__ void p0_item(const float* W, int N, int K, bf16* WT, int k0, int n0d, int csrc, int nvalid, int kxor, const float* ga, const float* gb, int gsplit, LAS float* scr, int lane) {
#pragma unroll 8
    for (int i = 0; i < 32; ++i) { const int kk = 2 * i + (lane >> 5), n = lane & 31, kd = k0 + kk;
        float v = (n < nvalid) ? W[(size_t)(kd ^ kxor) * N + csrc + n] : 0.f;
        if (ga) v *= (kd < gsplit) ? ga[kd] : gb[kd - gsplit];
        scr[kk * 33 + n] = v; }
    LDS_WAIT(); asm volatile("" ::: "memory");
    const int c = lane & 7;
#pragma unroll
    for (int j = 0; j < 4; ++j) { const int n = (lane >> 3) + 8 * j; const LAS float* s = scr + (8 * c) * 33 + n;
        v4u o; o.x = pk2(s[0 * 33], s[1 * 33]); o.y = pk2(s[2 * 33], s[3 * 33]); o.z = pk2(s[4 * 33], s[5 * 33]); o.w = pk2(s[6 * 33], s[7 * 33]);
        *(GAS v4u*)(WT + (size_t)(n0d + n) * K + k0 + 8 * c) = o; }
    LDS_WAIT(); asm volatile("" ::: "memory");
}
__device__ __forceinline__ void p0_w13(Frame& F, const float* W, const float* g, bf16* WT, int r, LAS float* scr) {
    const int nblk = 2 * DFF / 32, kb = r / nblk, nb = r % nblk, n0d = 32 * nb, t = n0d >> 8, o = n0d & 255;
    const int csrc = (o < 128) ? 128 * t + o : DFF + 128 * t + (o - 128);
    p0_item(W, 2 * DFF, D, WT, 64 * kb, n0d, csrc, 32, 0, g, g, D, scr, F.lane);
}
__device__ __forceinline__ void p0_w2(Frame& F, const float* W, bf16* WT, int r, LAS float* scr) {
    const int nblk = D / 32, kb = r / nblk, nb = r % nblk;
    p0_item(W, D, DFF, WT, 64 * kb, 32 * nb, 32 * nb, 32, 0, nullptr, nullptr, 0, scr, F.lane);
}
__device__ __forceinline__ void p0_win(Frame& F, int r, LAS float* scr) {
    const int nblk = NINP / 32, kb = r / nblk, nb = r % nblk, n0d = 32 * nb; int csrc, nvalid = 32;
    if (n0d < 1024) { const int t = n0d >> 8, o = n0d & 255; csrc = (o < 128) ? 128 * t + o : 512 + 128 * t + (o - 128); }
    else if (n0d < 2560) csrc = n0d;
    else if (n0d == 2560) { csrc = 2560; nvalid = 8; }
    else { csrc = 0; nvalid = 0; }
    p0_item(F.win, NIN, D, F.WIN, 64 * kb, n0d, csrc, nvalid, 0, F.gmix, F.gmix, D, scr, F.lane);
}
__device__ __forceinline__ void p0_wout(Frame& F, int r, LAS float* scr) {
    const int nblk = D / 32, kb = r / nblk, nb = r % nblk;
    p0_item(F.wout, D, D, F.WOUT, 64 * kb, 32 * nb, 32 * nb, 32, 512, F.gya, F.gyc, 512, scr, F.lane);
}
__device__ __forceinline__ void p0_row(Frame& F, int m) {
    const GAS f32x4* xr = (const GAS f32x4*)(F.x + (size_t)m * D) + F.lane;
    f32x4 v[4]; float s = 0.f;
#pragma unroll
    for (int j = 0; j < 4; ++j) { v[j] = xr[64 * j]; s += (v[j].x * v[j].x + v[j].y * v[j].y) + (v[j].z * v[j].z + v[j].w * v[j].w); }
    s = wave_sum(s);
    GAS unsigned long long* o8 = (GAS unsigned long long*)(F.XB + (size_t)m * D) + F.lane;
#pragma unroll
    for (int j = 0; j < 4; ++j) o8[64 * j] = (unsigned long long)pk2(v[j].x, v[j].y) | ((unsigned long long)pk2(v[j].z, v[j].w) << 32);
    if (F.lane == 0) F.RS0[m] = 1.0f / sqrtf(s * (1.0f / D) + EPS);
}
__device__ __forceinline__ void p0_prologue(Frame& F) {
    LAS float* scr = (LAS float*)(F.lds + RING_OFF + F.wave * 16384);
    const int gw = F.vcu * NWAVES + F.wave, NGW = F.G * NWAVES;
    constexpr int I_13 = (D / 64) * (2 * DFF / 32), I_2 = (DFF / 64) * (D / 32), I_IN = (D / 64) * (NINP / 32), I_OUT = (D / 64) * (D / 32);
    constexpr int NITEMS = 2 * I_13 + 2 * I_2 + I_IN + I_OUT;
    for (int it = gw; it < NITEMS; it += NGW) {
        int r = it;
        if (r < I_13) { p0_w13(F, F.w13a, F.g1, F.W13A, r, scr); continue; } r -= I_13;
        if (r < I_2) { p0_w2(F, F.w2a, F.W2A, r, scr); continue; } r -= I_2;
        if (r < I_IN) { p0_win(F, r, scr); continue; } r -= I_IN;
        if (r < I_OUT) { p0_wout(F, r, scr); continue; } r -= I_OUT;
        if (r < I_13) { p0_w13(F, F.w13b, F.g2, F.W13B, r, scr); continue; } r -= I_13;
        p0_w2(F, F.w2b, F.W2B, r, scr);
    }
    for (int m = gw; m < M; m += NGW) p0_row(F, m);
}
constexpr int CV_ROWS = 64 + CONVW - 1, STAT_OFF = 131072 + 2048;
static_assert(CV_ROWS * 1024 <= RING_BYTES && STAT_OFF + 1024 <= LDS_BYTES, "conv LDS");
__device__ __forceinline__ void conv_unit(Frame& F, int tile) {
    typedef float f32x2v __attribute__((ext_vector_type(2)));
    const int t0 = tile * 64, s0 = t0 & (SEQ - 1);
    LAS unsigned char* ub = F.lds + RING_OFF;
    for (int i = F.wave; i < CV_ROWS; i += NWAVES) {
        v4u v = (v4u){0u, 0u, 0u, 0u};
        if (s0 - (CONVW - 1) + i >= 0) v = *(const GAS v4u*)((const GAS unsigned char*)F.U + (size_t)(t0 - (CONVW - 1) + i) * 1024 + F.lane * 16);
        *(LAS v4u*)(ub + i * 1024 + F.lane * 16) = v;
    }
    const int cp = F.tid & 255, th = F.tid >> 8;
    f32x2v w[CONVW];
#pragma unroll
    for (int j = 0; j < CONVW; ++j) w[j] = *(const GAS f32x2v*)(F.cw + j * DCONV + 2 * cp);
    const f32x2v bias = *(const GAS f32x2v*)(F.cb + 2 * cp);
    LDS_WAIT(); __syncthreads();
    f32x2v acc[32];
    const LAS unsigned* up = (const LAS unsigned*)(ub + (32 * th) * 1024 + cp * 4);
#pragma unroll
    for (int k = 0; k < 4; ++k) {
        f32x2v a[8];
#pragma unroll
        for (int i = 0; i < 8; ++i) a[i] = bias;
#pragma unroll
        for (int rr = 0; rr < 8 + CONVW - 1; ++rr) {
            const unsigned x = up[(8 * k + rr) * 256];
            const f32x2v u = (f32x2v){__uint_as_float(x << 16), __uint_as_float(x & 0xffff0000u)};
#pragma unroll
            for (int i = 0; i < 8; ++i) { const int j = rr - i; if (j >= 0 && j < CONVW) a[i] += w[j] * u; }
        }
#pragma unroll
        for (int i = 0; i < 8; ++i) acc[8 * k + i] = a[i];
    }
    __syncthreads();
    LAS float* part = (LAS float*)ub;
#pragma unroll
    for (int tk = 0; tk < 32; ++tk) { const f32x2v a = acc[tk]; part[((th * 32 + tk) * 2) * 256 + cp] = a.x + a.y; part[((th * 32 + tk) * 2 + 1) * 256 + cp] = a.x * a.x + a.y * a.y; }
    LDS_WAIT(); __syncthreads();
    LAS f32x2v* stat = (LAS f32x2v*)(F.lds + STAT_OFF); LAS float* stat2 = (LAS float*)(F.lds + STAT_OFF + 512);
    {   const int row = F.tid >> 2, qd = F.tid & 3; const LAS f32x4* rp = (const LAS f32x4*)(ub + row * 1024 + qd * 256); float s = 0.f;
#pragma unroll
        for (int i = 0; i < 16; ++i) { const f32x4 v = rp[(i + F.lane) & 15]; s += (v.x + v.y) + (v.z + v.w); }
        s += __shfl_xor(s, 1); s += __shfl_xor(s, 2);
        const float sq = __shfl_down(s, 4);
        if ((F.tid & 7) == 0) { const float mean = s * (1.0f / DCONV), var = fmaxf(sq * (1.0f / DCONV) - mean * mean, 0.f); stat[F.tid >> 3] = (f32x2v){mean, 1.0f / sqrtf(var + EPS)}; } }
    LDS_WAIT(); __syncthreads();
    const f32x2v lg = *(const GAS f32x2v*)(F.lng + 2 * cp), lb = *(const GAS f32x2v*)(F.lnb + 2 * cp);
#pragma unroll
    for (int tk = 0; tk < 32; ++tk) { const f32x2v st = stat[th * 32 + tk]; f32x2v v = (acc[tk] - st.x) * st.y * lg + lb; v.x = v.x * pg8::sigmoid_f(v.x); v.y = v.y * pg8::sigmoid_f(v.y); acc[tk] = v;
        part[(th * 32 + tk) * 256 + cp] = v.x * v.x + v.y * v.y; }
    LDS_WAIT(); __syncthreads();
    {   const int row = F.tid >> 3, e = F.tid & 7; const LAS f32x4* rp = (const LAS f32x4*)(ub + row * 1024 + e * 128); float s = 0.f;
#pragma unroll
        for (int i = 0; i < 8; ++i) { const f32x4 v = rp[(i + F.lane + (F.lane >> 3)) & 7]; s += (v.x + v.y) + (v.z + v.w); }
        s += __shfl_xor(s, 1); s += __shfl_xor(s, 2); s += __shfl_xor(s, 4);
        if (e == 0) stat2[row] = 1.0f / sqrtf(s * (1.0f / DCONV) + EPS); }
    LDS_WAIT(); __syncthreads();
    GAS unsigned* yo = (GAS unsigned*)(F.Y + (size_t)(t0 + th * 32) * D + 512 + 2 * cp);
#pragma unroll
    for (int tk = 0; tk < 32; ++tk) { const float r = stat2[th * 32 + tk]; yo[(size_t)tk * (D / 2)] = pk2(acc[tk].x * r, acc[tk].y * r); }
}
__device__ __forceinline__ void final_rows(Frame& F) {
    const int gw = F.vcu * NWAVES + F.wave, NGW = F.G * NWAVES;
    const GAS f32x4* g4 = (const GAS f32x4*)F.gfin + F.lane;
    for (int m = gw; m < M; m += NGW) {
        const f32x4 p = *(const GAS f32x4*)(F.SSQ3 + 4 * (size_t)m);
        const float r = 1.0f / sqrtf(((p.x + p.y) + (p.z + p.w)) * (1.0f / D) + EPS);
        GAS f32x4* xr = (GAS f32x4*)(F.out + (size_t)m * D) + F.lane;
#pragma unroll
        for (int j = 0; j < 4; ++j) { const f32x4 v = xr[64 * j], g = g4[64 * j]; xr[64 * j] = v * r * g; }
    }
}

#ifndef PH_MASK
#define PH_MASK 0x1ff
#endif
#define PH(k) ((PH_MASK >> (k)) & 1)
struct Args { const float* in[18]; float* out; unsigned char* ws; };
__global__ void __launch_bounds__(NWAVES * 64, 2) mk_fwd(Args args) {
    extern __shared__ __attribute__((aligned(16))) unsigned char lds[];
    Frame F;
    F.lds = (LAS unsigned char*)lds;
    F.MISC = (volatile LAS unsigned*)(F.lds + MISC_OFF);
    F.tid = threadIdx.x; F.lane = F.tid & 63; F.wave = __builtin_amdgcn_readfirstlane(F.tid >> 6);
    F.G = gridDim.x; { const int bx = blockIdx.x; F.vcu = (F.G % 8 == 0) ? (bx % 8) * (F.G / 8) + bx / 8 : bx; }
    unsigned char* ws = args.ws;
    F.ctl = (gu32*)(ws + WS_CTL);
    F.x = args.in[0]; F.g1 = args.in[1]; F.w13a = args.in[2]; F.w2a = args.in[3]; F.gmix = args.in[4]; F.win = args.in[5]; F.cw = args.in[6]; F.cb = args.in[7]; F.lng = args.in[8]; F.lnb = args.in[9];
    F.fb = args.in[10]; F.gyc = args.in[11]; F.gya = args.in[12]; F.wout = args.in[13]; F.g2 = args.in[14]; F.w13b = args.in[15]; F.w2b = args.in[16]; F.gfin = args.in[17]; F.out = args.out;
    F.W13A = (bf16*)(ws + WS_W13A); F.W2A = (bf16*)(ws + WS_W2A); F.WIN = (bf16*)(ws + WS_WIN); F.WOUT = (bf16*)(ws + WS_WOUT); F.W13B = (bf16*)(ws + WS_W13B); F.W2B = (bf16*)(ws + WS_W2B);
    F.XB = (bf16*)(ws + WS_XB); F.ACT = (bf16*)(ws + WS_ACT); F.U = (bf16*)(ws + WS_U); F.KV = (bf16*)(ws + WS_KV); F.Y = (bf16*)(ws + WS_Y);
    F.LF = (float*)(ws + WS_LF); F.RS0 = (float*)(ws + WS_RS0); F.SSQ1 = (float*)(ws + WS_SSQ1); F.SSQ2 = (float*)(ws + WS_SSQ2); F.SSQ3 = (float*)(ws + WS_SSQ3); F.SSQA = (float*)(ws + WS_SSQA);
    for (int u = F.tid; u < (LDS_BYTES - LDSCTL_OFF) / 4; u += NWAVES * 64) ((LAS unsigned*)(F.lds + LDSCTL_OFF))[u] = 0u;
    __syncthreads();
    XcdBarrier bar = xcd_barrier_post((unsigned*)(F.ctl + CW_BAR), F.MISC + 8);
#define GRID_BAR() xcd_barrier(bar)

    if (PH(0)) { FRAME_REFRESH(F); p0_prologue(F); }
    GRID_BAR();
    if (PH(1)) {   pg8::Gemm g{F.XB, F.W13A, M, 2 * DFF, D}; pg8::StaticOrder S; S.init(M, 2 * DFF, F.G, (int)blockIdx.x);
        pg8::EpiSwiglu<1> E{F.ACT, F.RS0};
        pg8::gemm_phase<pg8::EpiSwiglu<1>, pg8::StaticOrder, true, true>(F.lds + RING_OFF, g, S, E); }
    GRID_BAR();
    if (PH(2)) {   pg8::Gemm g{F.ACT, F.W2A, M, D, DFF}; pg8::StaticOrder S; S.init(M, D, F.G, (int)blockIdx.x);
        pg8::EpiResid<0> E{F.x, F.out, F.XB, F.SSQ1, 0.5f};
        pg8::gemm_phase<pg8::EpiResid<0>, pg8::StaticOrder, false, true>(F.lds + RING_OFF, g, S, E); }
    GRID_BAR();
    if (PH(3)) {   pg8::Gemm g{F.XB, F.WIN, M, NINP, D}; pg8::StaticOrder S; S.init(M, NINP, F.G, (int)blockIdx.x);
        pg8::EpiInProj E{F.U, F.Y, F.KV, F.LF, F.SSQ1, F.fb, attn_body::C2};
        pg8::gemm_phase<pg8::EpiInProj, pg8::StaticOrder, true, true>(F.lds + RING_OFF, g, S, E); }
    GRID_BAR();
    if (PH(4)) {
#ifndef NO_CONV
        FRAME_REFRESH(F); conv_unit(F, F.vcu);
#endif
#ifndef NO_ATTN
        static_assert(attn_body::ATTN_LDS_BYTES <= RING_BYTES && attn_body::ATTN_PITCH == D, "attention body geometry vs frame");
        const attn_body::AttnTensors AT{(const attn_body::bf16*)F.Y, (const attn_body::bf16*)F.KV, (const attn_body::bf16*)(F.KV + 512), (attn_body::bf16*)F.Y, F.LF, F.SSQA};
        const attn_body::StaticOrder S((int)F.G, (int)blockIdx.x);
        attn_body::attn_phase<attn_body::StaticOrder>((char*)lds + RING_OFF, AT, S);
#endif
    }
    GRID_BAR();
    if (PH(5)) {
        FRAME_REFRESH(F);
        pg8::Gemm g{F.Y, F.WOUT, M, D, D}; pg8::StaticOrder S; S.init(M, D, F.G, (int)blockIdx.x);
        pg8::Unit u0; S.next(0, u0);
        if (F.tid < 256) { const GAS f32x4* p = (const GAS f32x4*)(F.SSQA + (size_t)(u0.pm * 256 + F.tid) * NH); const f32x4 a = p[0], b = p[1];
            ((LAS float*)(F.lds + RSC_OFF))[F.tid] = 1.0f / sqrtf((((a.x + a.y) + (a.z + a.w)) + ((b.x + b.y) + (b.z + b.w))) * (1.0f / DATTN) + EPS); }
        LDS_WAIT(); __syncthreads();
        pg8::EpiResid<8> E{F.out, F.out, F.XB, F.SSQ2, 1.0f};
        pg8::gemm_phase<pg8::EpiResid<8>, pg8::StaticOrder, false, true>(F.lds + RING_OFF, g, S, E); }
    GRID_BAR();
    if (PH(6)) {   pg8::Gemm g{F.XB, F.W13B, M, 2 * DFF, D}; pg8::StaticOrder S; S.init(M, 2 * DFF, F.G, (int)blockIdx.x);
        pg8::EpiSwiglu<4> E{F.ACT, F.SSQ2};
        pg8::gemm_phase<pg8::EpiSwiglu<4>, pg8::StaticOrder, true, true>(F.lds + RING_OFF, g, S, E); }
    GRID_BAR();
    if (PH(7)) {   pg8::Gemm g{F.ACT, F.W2B, M, D, DFF}; pg8::StaticOrder S; S.init(M, D, F.G, (int)blockIdx.x);
        pg8::EpiResid<0> E{F.out, F.out, nullptr, F.SSQ3, 0.5f};
        pg8::gemm_phase<pg8::EpiResid<0>, pg8::StaticOrder, false, true>(F.lds + RING_OFF, g, S, E); }
    GRID_BAR();
    if (PH(8)) { FRAME_REFRESH(F); final_rows(F); }
}

extern "C" void kernel_launch(void* const* d_in, const int* in_sizes, int n_in, void* d_out, int out_size, void* d_ws, size_t ws_size, hipStream_t stream) {
    static int grid = 0;
    if (grid == 0) {
        if (n_in != 18 || in_sizes[0] != M * D || out_size != M * D || ws_size < WS_END) { fprintf(stderr, "kernel_launch: unexpected shapes (n_in %d, in0 %d, out %d, ws %zu); nothing launched\n", n_in, n_in > 0 ? in_sizes[0] : -1, out_size, ws_size); grid = -1; return; }
        int dev = 0, cus = 0, per_cu = 0;
        if (hipGetDevice(&dev) != hipSuccess || hipDeviceGetAttribute(&cus, hipDeviceAttributeMultiprocessorCount, dev) != hipSuccess) { fprintf(stderr, "kernel_launch: device query failed\n"); grid = -1; return; }
        if (hipFuncSetAttribute((const void*)mk_fwd, hipFuncAttributeMaxDynamicSharedMemorySize, LDS_BYTES) != hipSuccess) { fprintf(stderr, "kernel_launch: hipFuncSetAttribute failed\n"); grid = -1; return; }
        if (hipOccupancyMaxActiveBlocksPerMultiprocessor(&per_cu, (const void*)mk_fwd, NWAVES * 64, LDS_BYTES) != hipSuccess || per_cu < 1) { fprintf(stderr, "kernel_launch: occupancy query reports %d workgroups per CU; nothing launched\n", per_cu); (void)hipGetLastError(); grid = -1; return; }
        (void)hipGetLastError();
        grid = cus;
        if (grid != 256) { fprintf(stderr, "kernel_launch: %d CUs; this kernel is built for 256\n", grid); grid = -1; return; }
    }
    if (grid < 0) return;
    if (hipMemsetAsync((char*)d_ws + WS_CTL, 0, CTL_ZERO_BYTES, stream) != hipSuccess) { fprintf(stderr, "kernel_launch: hipMemsetAsync failed\n"); return; }
    Args a{};
    for (int i = 0; i < 18; ++i) a.in[i] = (const float*)d_in[i];
    a.out = (float*)d_out; a.ws = (unsigned char*)d_ws;
    hipLaunchKernelGGL(mk_fwd, dim3(grid), dim3(NWAVES * 64), LDS_BYTES, stream, a);
    const hipError_t le = hipPeekAtLastError();
    if (le != hipSuccess) fprintf(stderr, "kernel_launch: launch failed: %s\n", hipGetErrorName(le));
}
```

```cpp
#include <hip/hip_runtime.h>
#include <cstdio>
#include <cstdint>
constexpr int RSC_OFF = 131072 + 1024;
constexpr int FF_DIM = 2816;
__device__ __forceinline__ int opaque_tid() { int t = threadIdx.x; asm volatile("" : "+v"(t)); return t; }
namespace pg8 {
#define PG8_LAS __attribute__((address_space(3)))
typedef unsigned short bf16_t;
typedef short bf16x8 __attribute__((ext_vector_type(8)));
typedef float f32x4 __attribute__((ext_vector_type(4)));
typedef unsigned u32x4 __attribute__((ext_vector_type(4)));
constexpr int BM = 256, BK = 64, HALF = 128, HTB = HALF * BK * 2  , STAGE_BYTES = 8 * HTB, NXCD = 8, WGM = 8;

__host__ __device__ __forceinline__ int lds_byte(int r, int c) { const int st = (r >> 4) * 2 + (c >> 5), rr = r & 15, cc = c & 31, ob = rr * 64 + cc * 2; return st * 1024 + (ob ^ (((ob >> 9) & 1) << 5)); }
__host__ __device__ __forceinline__ void stage_rc(int b, int& R, int& C) { const int st = b / 1024, sb = b % 1024, swz = sb ^ (((sb >> 9) & 1) << 5); R = (st >> 1) * 16 + swz / 64; C = (st & 1) * 32 + (swz % 64) / 2; }
__host__ __device__ __forceinline__ int perm32(int rho) { const int n = rho >> 4, i = rho & 15; return 8 * (i >> 2) + 4 * n + (i & 3); }

struct Unit { int pm, pn; };
struct Gemm { const bf16_t* A; const bf16_t* Bt; int M, N, K; };

struct StaticOrder {
    int nM, nN, nwg, G, c;
    __host__ __device__ void init(int M, int N, int G_, int c_) { nM = M / BM; nN = N / BM; nwg = nM * nN; G = G_; c = c_; }
    __host__ __device__ bool next(int i, Unit& u) const {
        const long L = (long)i * G + c; if (L >= nwg) return false;
        int wgid = (int)L; { const int q = nwg / NXCD, r = nwg % NXCD, xcd = wgid % NXCD, off = wgid / NXCD; wgid = (xcd < r ? xcd * (q + 1) : r * (q + 1) + (xcd - r) * q) + off; }
        const int nig = WGM * nN, gid = wgid / nig, fm = gid * WGM, gsz = (nM - fm) < WGM ? (nM - fm) : WGM;
        u.pm = fm + ((wgid % nig) % gsz); u.pn = (wgid % nig) / gsz; return true;
    }
    __device__ __forceinline__ void a_ready(const Unit&) const {}
    __device__ __forceinline__ void done(const Unit&) const {}
};
__device__ __forceinline__ unsigned cvt_pk_bf16(float lo, float hi) { unsigned r; asm volatile("v_cvt_pk_bf16_f32 %0, %1, %2" : "=v"(r) : "v"(lo), "v"(hi)); return r; }
constexpr float RMS_EPS = 1e-6f, LOG2E = 1.4426950408889634f;
__device__ __forceinline__ float rs_from4(const float* ssq, int row) { const f32x4 p = *(const f32x4*)(ssq + 4 * (size_t)row); return __builtin_amdgcn_rsqf(((p[0] + p[1]) + (p[2] + p[3])) * (1.0f / 1024.0f) + RMS_EPS); }
__device__ __forceinline__ float sigmoid_f(float v) { return __builtin_amdgcn_rcpf(1.0f + __builtin_amdgcn_exp2f(-v * LOG2E)); }

template <int RSN> struct EpiSwiglu {
    static constexpr bool PERM = true, AFTER_DRAIN = false; static constexpr int MIDK = 0;
    bf16_t* O; const float* rs;
    __device__ __forceinline__ void operator()(const f32x4 (&acc)[2][2][4][2], const Unit& u, int wr, int wc, int fr, int fq) const {
        const int row0 = u.pm * BM + wr * 64 + fr, col0 = u.pn * 128 + wc * 32 + 8 * fq;
        float rsc[2][4];
#pragma unroll
        for (int ai = 0; ai < 2; ++ai)
#pragma unroll
            for (int m = 0; m < 4; ++m) { const int row = row0 + ai * HALF + m * 16; rsc[ai][m] = (RSN == 1) ? rs[row] : rs_from4(rs, row); }
#pragma unroll
        for (int ai = 0; ai < 2; ++ai)
#pragma unroll
            for (int m = 0; m < 4; ++m) { const float r = rsc[ai][m]; float h[8];
#pragma unroll
                for (int n = 0; n < 2; ++n)
#pragma unroll
                    for (int i = 0; i < 4; ++i) { const float g = acc[ai][0][m][n][i] * r, up = acc[ai][1][m][n][i] * r; h[4 * n + i] = g * up * sigmoid_f(g); }
                u32x4 w; w.x = cvt_pk_bf16(h[0], h[1]); w.y = cvt_pk_bf16(h[2], h[3]); w.z = cvt_pk_bf16(h[4], h[5]); w.w = cvt_pk_bf16(h[6], h[7]);
                *(u32x4*)(O + (size_t)(row0 + ai * HALF + m * 16) * FF_DIM + col0) = w; }
    }
};
struct EpiInProj {
    static constexpr bool PERM = true, AFTER_DRAIN = false; static constexpr int MIDK = 0;
    bf16_t* U; bf16_t* Y; bf16_t* KV; float* LF; const float* ssq; const float* fb; float qscale;
    __device__ __forceinline__ void operator()(const f32x4 (&acc)[2][2][4][2], const Unit& u, int wr, int wc, int fr, int fq) const {
        const int row0 = u.pm * BM + wr * 64 + fr, pn = u.pn;
        float rsc[2][4];
#pragma unroll
        for (int ai = 0; ai < 2; ++ai)
#pragma unroll
            for (int m = 0; m < 4; ++m) rsc[ai][m] = rs_from4(ssq, row0 + ai * HALF + m * 16);
        if (pn < 4) {
            const int col0 = pn * 128 + wc * 32 + 8 * fq;
#pragma unroll
            for (int ai = 0; ai < 2; ++ai)
#pragma unroll
                for (int m = 0; m < 4; ++m) { const float r = rsc[ai][m]; float h[8];
#pragma unroll
                    for (int n = 0; n < 2; ++n)
#pragma unroll
                        for (int i = 0; i < 4; ++i) { const float a = acc[ai][0][m][n][i] * r, g = acc[ai][1][m][n][i] * r; h[4 * n + i] = a * sigmoid_f(g); }
                    u32x4 w; w.x = cvt_pk_bf16(h[0], h[1]); w.y = cvt_pk_bf16(h[2], h[3]); w.z = cvt_pk_bf16(h[4], h[5]); w.w = cvt_pk_bf16(h[6], h[7]);
                    *(u32x4*)(U + (size_t)(row0 + ai * HALF + m * 16) * 512 + col0) = w; }
        } else if (pn < 10) {
            bf16_t* dst = (pn < 6) ? Y + (pn - 4) * 256 : (pn < 8) ? KV + (pn - 6) * 256 : KV + 512 + (pn - 8) * 256;
            const float sc = (pn < 6) ? qscale : 1.0f; const int col0 = wc * 32 + 8 * fq;
#pragma unroll
            for (int ai = 0; ai < 2; ++ai)
#pragma unroll
                for (int m = 0; m < 4; ++m) { const float r = rsc[ai][m] * sc; bf16_t* rowp = dst + (size_t)(row0 + ai * HALF + m * 16) * 1024 + col0;
#pragma unroll
                    for (int bj = 0; bj < 2; ++bj) { const f32x4 v0 = acc[ai][bj][m][0] * r, v1 = acc[ai][bj][m][1] * r;
                        u32x4 w; w.x = cvt_pk_bf16(v0[0], v0[1]); w.y = cvt_pk_bf16(v0[2], v0[3]); w.z = cvt_pk_bf16(v1[0], v1[1]); w.w = cvt_pk_bf16(v1[2], v1[3]);
                        *(u32x4*)(rowp + bj * HALF) = w; } }
        } else {
            if (wc == 0 && fq == 0) {
                float fbv[8];
#pragma unroll
                for (int h = 0; h < 8; ++h) fbv[h] = fb[h];
#pragma unroll
                for (int ai = 0; ai < 2; ++ai)
#pragma unroll
                    for (int m = 0; m < 4; ++m) { const int row = row0 + ai * HALF + m * 16; const float r = rsc[ai][m]; const int b = row >> 11, s = row & 2047;
#pragma unroll
                        for (int h = 0; h < 8; ++h) { const float z = acc[ai][0][m][h >> 2][h & 3] * r + fbv[h];
                            const float ls2 = fminf(z, 0.f) * LOG2E - __builtin_amdgcn_logf(1.0f + __builtin_amdgcn_exp2f(-fabsf(z) * LOG2E));
                            LF[((size_t)(b * 8 + h) << 11) + s] = ls2; } }
            }
        }
    }
};
template <int MIDK_> struct EpiResid {
    static constexpr bool PERM = true, AFTER_DRAIN = true; static constexpr int MIDK = MIDK_;
    const float* base; float* out; bf16_t* xb; float* ssq; float scale;
    __device__ __forceinline__ void midk(f32x4 (&acc)[2][2][4][2], int wr, int fr, PG8_LAS unsigned char* lds) const {
        const PG8_LAS float* rsc = (const PG8_LAS float*)(lds + RSC_OFF);
#pragma unroll
        for (int ai = 0; ai < 2; ++ai)
#pragma unroll
            for (int m = 0; m < 4; ++m) { const float r = rsc[ai * HALF + wr * 64 + m * 16 + fr];
#pragma unroll
                for (int bj = 0; bj < 2; ++bj)
#pragma unroll
                    for (int n = 0; n < 2; ++n) acc[ai][bj][m][n] *= r; }
    }
    __device__ __forceinline__ void fused(f32x4 (&acc)[2][2][4][2], const Unit& u, int wr, int wc, int fr, int fq, PG8_LAS unsigned char* lds, int wid, int lane) const {
        PG8_LAS float* P = (PG8_LAS float*)lds;
        const int col0 = u.pn * BM + wc * 32 + 8 * fq;
#pragma unroll
        for (int ai = 0; ai < 2; ++ai)
#pragma unroll
            for (int m = 0; m < 4; ++m) { const int rl = ai * HALF + wr * 64 + m * 16 + fr; const size_t off = (size_t)(u.pm * BM + rl) * 1024 + col0; float s = 0.f;
#pragma unroll
                for (int bj = 0; bj < 2; ++bj) { const f32x4 b0 = *(const f32x4*)(base + off + bj * HALF), b1 = *(const f32x4*)(base + off + bj * HALF + 4);
                    const f32x4 v0 = b0 + acc[ai][bj][m][0] * scale, v1 = b1 + acc[ai][bj][m][1] * scale;
                    *(f32x4*)(out + off + bj * HALF) = v0; *(f32x4*)(out + off + bj * HALF + 4) = v1;
                    s += (v0[0] * v0[0] + v0[1] * v0[1]) + (v0[2] * v0[2] + v0[3] * v0[3]) + (v1[0] * v1[0] + v1[1] * v1[1]) + (v1[2] * v1[2] + v1[3] * v1[3]);
                    if (xb) { u32x4 w; w.x = cvt_pk_bf16(v0[0], v0[1]); w.y = cvt_pk_bf16(v0[2], v0[3]); w.z = cvt_pk_bf16(v1[0], v1[1]); w.w = cvt_pk_bf16(v1[2], v1[3]); *(u32x4*)(xb + off + bj * HALF) = w; } }
                s += __shfl_xor(s, 16); s += __shfl_xor(s, 32);
                if (fq == 0) P[rl * 4 + wc] = s;
                if (m & 1) asm volatile("" ::: "memory"); }
        asm volatile("s_waitcnt lgkmcnt(0)" ::: "memory"); __builtin_amdgcn_s_barrier(); asm volatile("" ::: "memory");
        const int t = wid * 64 + lane;
        if (t < 256) { const PG8_LAS f32x4* P4 = (const PG8_LAS f32x4*)lds; const f32x4 p = P4[t]; ssq[(size_t)(u.pm * BM + t) * 4 + u.pn] = (p[0] + p[1]) + (p[2] + p[3]); }
    }
};

template <class Epi, class Sched, bool ALIGN_EPI = false, bool SP2 = false>
__device__ __forceinline__ void gemm_phase(PG8_LAS unsigned char* lds, const Gemm g, const Sched& S, const Epi& E) {
    const int tid = opaque_tid(), wid = __builtin_amdgcn_readfirstlane(tid >> 6), lane = tid & 63, wr = wid >> 2, wc = wid & 3, fr = lane & 15, fq = lane >> 4;
    const int K = g.K, nt = K / BK;
    static_assert(SP2 || Epi::MIDK == 0, "mid-K hook only in the SP2 loop");
    unsigned voffA[2], voffB[2];
#pragma unroll
    for (int i = 0; i < 2; ++i) { int R, C; stage_rc(tid * 16 + i * 8192, R, C); const int Rb = Epi::PERM ? ((R & ~31) + perm32(R & 31)) : R;
        voffA[i] = (unsigned)(R * K + C) * 2u; voffB[i] = (unsigned)(Rb * K + C) * 2u; }
    const size_t kstep = (size_t)(BK * 2);
    const size_t hstep = (size_t)HALF * K * 2;
    const size_t tstep = 2 * hstep;
    const unsigned ldsw = (unsigned)wid * 1024u;
    const int aoff = lds_byte(wr * 64 + fr, fq * 8), boff = lds_byte(wc * 32 + fr, fq * 8);
#define PG8_SA(b, h) (((b) * 2 + (h)) * HTB)
#define PG8_SB(b, h) ((4 + (b) * 2 + (h)) * HTB)
#define PG8_STAGE(bufoff, gbase, voff) do { _Pragma("unroll") for (int _i = 0; _i < 2; ++_i) \
        __builtin_amdgcn_global_load_lds((const unsigned*)((const char*)(gbase) + (voff)[_i]), (PG8_LAS unsigned*)(lds + (bufoff) + ldsw + _i * 8192), 16, 0, 0); } while (0)
#define PG8_LDA(dst, b, h) do { _Pragma("unroll") for (int m = 0; m < 4; ++m) _Pragma("unroll") for (int k = 0; k < 2; ++k) dst[m][k] = *(const PG8_LAS bf16x8*)(lds + PG8_SA(b, h) + aoff + m * 2048 + k * 1024); } while (0)
#define PG8_LDB(dst, b, h) do { _Pragma("unroll") for (int n = 0; n < 2; ++n) _Pragma("unroll") for (int k = 0; k < 2; ++k) dst[n][k] = *(const PG8_LAS bf16x8*)(lds + PG8_SB(b, h) + boff + n * 2048 + k * 1024); } while (0)
#define PG8_MMA(ai, bj, At, Bt) do { __builtin_amdgcn_s_setprio(1); _Pragma("unroll") for (int m = 0; m < 4; ++m) _Pragma("unroll") for (int n = 0; n < 2; ++n) _Pragma("unroll") for (int k = 0; k < 2; ++k) \
        acc[ai][bj][m][n] = __builtin_amdgcn_mfma_f32_16x16x32_bf16(Bt[n][k], At[m][k], acc[ai][bj][m][n], 0, 0, 0); __builtin_amdgcn_s_setprio(0); } while (0)
#define PG8_WAIT_V(n) asm volatile("s_waitcnt vmcnt(" #n ")" ::: "memory")
#define PG8_WAIT_L(n) asm volatile("s_waitcnt lgkmcnt(" #n ")" ::: "memory")
#define PG8_BAR __builtin_amdgcn_s_barrier()
#define PG8_SCHED __builtin_amdgcn_sched_barrier(0)
    Unit cur, nxt; int ui = 0;
    if (!S.next(0, cur)) return;
    f32x4 acc[2][2][4][2];
#pragma unroll
    for (int a = 0; a < 2; ++a)
#pragma unroll
        for (int b = 0; b < 2; ++b)
#pragma unroll
            for (int m = 0; m < 4; ++m)
#pragma unroll
                for (int n = 0; n < 2; ++n) acc[a][b][m][n] = (f32x4){0.f, 0.f, 0.f, 0.f};
    bf16x8 At[4][2], B0[2][2], B1[2][2];
    const char* cA = (const char*)g.A + (size_t)cur.pm * tstep; const char* cB = (const char*)g.Bt + (size_t)cur.pn * tstep;
    S.a_ready(cur);
    if constexpr (SP2) {
        PG8_STAGE(PG8_SB(0, 0), cB, voffB); PG8_STAGE(PG8_SB(0, 1), cB + hstep, voffB); PG8_STAGE(PG8_SA(0, 0), cA, voffA); PG8_STAGE(PG8_SA(0, 1), cA + hstep, voffA);
        if (wr == 1) PG8_BAR;
        PG8_WAIT_V(2); PG8_BAR;
        PG8_STAGE(PG8_SB(1, 0), cB + kstep, voffB); PG8_STAGE(PG8_SA(1, 0), cA + kstep, voffA); PG8_STAGE(PG8_SB(1, 1), cB + hstep + kstep, voffB);
        PG8_WAIT_V(6); PG8_BAR;
    } else {
        PG8_STAGE(PG8_SB(0, 0), cB, voffB); PG8_STAGE(PG8_SA(0, 0), cA, voffA); PG8_STAGE(PG8_SB(0, 1), cB + hstep, voffB); PG8_STAGE(PG8_SA(0, 1), cA + hstep, voffA);
        if (wr == 1) PG8_BAR;
        PG8_WAIT_V(4); PG8_BAR;
        PG8_STAGE(PG8_SB(1, 0), cB + kstep, voffB); PG8_STAGE(PG8_SA(1, 0), cA + kstep, voffA); PG8_STAGE(PG8_SB(1, 1), cB + hstep + kstep, voffB);
        PG8_WAIT_V(6); PG8_BAR;
    }
    for (;;) {
        const bool has_next = S.next(ui + 1, nxt);
        const char* nA = has_next ? (const char*)g.A + (size_t)nxt.pm * tstep : cA; const char* nB = has_next ? (const char*)g.Bt + (size_t)nxt.pn * tstep : cB;
        for (int t = 0; t < nt; t += 2) {
            const bool last = (t == nt - 2);
            const char* a1 = cA + (size_t)(t + 1) * kstep;
            const char* a2 = last ? nA : cA + (size_t)(t + 2) * kstep; const char* b2 = last ? nB : cB + (size_t)(t + 2) * kstep;
            const char* a3 = a2 + kstep; const char* b3 = b2 + kstep;
            if (last && has_next) S.a_ready(nxt);
            if constexpr (SP2) {
            PG8_LDB(B0, 0, 0); PG8_LDB(B1, 0, 1); PG8_SCHED; PG8_LDA(At, 0, 0); PG8_STAGE(PG8_SA(1, 1), a1 + hstep, voffA);
            PG8_WAIT_V(8); PG8_WAIT_L(0); PG8_BAR; PG8_MMA(0, 0, At, B0); PG8_MMA(0, 1, At, B1); PG8_BAR; PG8_SCHED;
            PG8_LDA(At, 0, 1); PG8_STAGE(PG8_SB(0, 0), b2, voffB); PG8_STAGE(PG8_SB(0, 1), b2 + hstep, voffB); PG8_STAGE(PG8_SA(0, 0), a2, voffA);
            PG8_WAIT_V(8); PG8_WAIT_L(0); PG8_BAR; PG8_MMA(1, 0, At, B0); PG8_MMA(1, 1, At, B1); PG8_BAR; PG8_SCHED;
            PG8_LDB(B0, 1, 0); PG8_LDB(B1, 1, 1); PG8_SCHED; PG8_LDA(At, 1, 0); PG8_STAGE(PG8_SA(0, 1), a2 + hstep, voffA);
            PG8_WAIT_V(8); PG8_WAIT_L(0); PG8_BAR; PG8_MMA(0, 0, At, B0); PG8_MMA(0, 1, At, B1); PG8_BAR; PG8_SCHED;
            PG8_LDA(At, 1, 1); PG8_STAGE(PG8_SB(1, 0), b3, voffB); PG8_STAGE(PG8_SB(1, 1), b3 + hstep, voffB); PG8_STAGE(PG8_SA(1, 0), a3, voffA);
            PG8_WAIT_V(8); PG8_WAIT_L(0); PG8_BAR; PG8_MMA(1, 0, At, B0); PG8_MMA(1, 1, At, B1); PG8_BAR; PG8_SCHED;
            if constexpr (Epi::MIDK > 0) { if (t + 2 == Epi::MIDK) { E.midk(acc, wr, fr, lds); PG8_SCHED; } }
            } else {
            PG8_LDB(B0, 0, 0); PG8_SCHED; PG8_LDA(At, 0, 0); PG8_STAGE(PG8_SA(1, 1), a1 + hstep, voffA);
            PG8_WAIT_L(8); PG8_BAR; PG8_WAIT_L(0); PG8_MMA(0, 0, At, B0); PG8_BAR; PG8_SCHED;
            PG8_LDB(B1, 0, 1); PG8_STAGE(PG8_SB(0, 0), b2, voffB);
            PG8_BAR; PG8_WAIT_L(0); PG8_MMA(0, 1, At, B1); PG8_BAR;
            PG8_LDA(At, 0, 1); PG8_STAGE(PG8_SA(0, 0), a2, voffA);
            PG8_BAR; PG8_WAIT_L(0); PG8_MMA(1, 0, At, B0); PG8_BAR; PG8_SCHED;
            PG8_STAGE(PG8_SB(0, 1), b2 + hstep, voffB);
            PG8_WAIT_V(6); PG8_BAR; PG8_MMA(1, 1, At, B1); PG8_BAR;
            PG8_LDB(B0, 1, 0); PG8_SCHED; PG8_LDA(At, 1, 0); PG8_STAGE(PG8_SA(0, 1), a2 + hstep, voffA);
            PG8_WAIT_L(8); PG8_BAR; PG8_WAIT_L(0); PG8_MMA(0, 0, At, B0); PG8_BAR; PG8_SCHED;
            PG8_LDB(B1, 1, 1); PG8_STAGE(PG8_SB(1, 0), b3, voffB);
            PG8_BAR; PG8_WAIT_L(0); PG8_MMA(0, 1, At, B1); PG8_BAR;
            PG8_LDA(At, 1, 1); PG8_STAGE(PG8_SA(1, 0), a3, voffA);
            PG8_BAR; PG8_WAIT_L(0); PG8_MMA(1, 0, At, B0); PG8_BAR; PG8_SCHED;
            PG8_STAGE(PG8_SB(1, 1), b3 + hstep, voffB);
            PG8_WAIT_V(6); PG8_BAR; PG8_MMA(1, 1, At, B1); PG8_BAR;
            }
        }
        if constexpr (ALIGN_EPI) { if (wr == 0) PG8_BAR; }
        if constexpr (!Epi::AFTER_DRAIN) { E(acc, cur, wr, wc, fr, fq); S.done(cur); }
        if (!has_next) break;
#pragma unroll
        for (int a = 0; a < 2; ++a)
#pragma unroll
            for (int b = 0; b < 2; ++b)
#pragma unroll
                for (int m = 0; m < 4; ++m)
#pragma unroll
                    for (int n = 0; n < 2; ++n) acc[a][b][m][n] = (f32x4){0.f, 0.f, 0.f, 0.f};
        cur = nxt; cA = nA; cB = nB; ++ui;
        if constexpr (ALIGN_EPI) { if (wr == 1) PG8_BAR; }
    }
    PG8_WAIT_V(0);
    if constexpr (!ALIGN_EPI) { if (wr == 0) PG8_BAR; }
    PG8_BAR;
#ifdef PROBE_EPI_REP
    if constexpr (Epi::AFTER_DRAIN) { if (E.base != E.out) for (int r_ = 0; r_ < PROBE_EPI_REP; ++r_) { E.fused(acc, cur, wr, wc, fr, fq, lds, wid, lane); asm volatile("s_waitcnt vmcnt(0) lgkmcnt(0)" ::: "memory"); __builtin_amdgcn_s_barrier(); } }
#endif
    if constexpr (Epi::AFTER_DRAIN) { E.fused(acc, cur, wr, wc, fr, fq, lds, wid, lane); S.done(cur); }
#undef PG8_SA
#undef PG8_SB
#undef PG8_STAGE
#undef PG8_LDA
#undef PG8_LDB
#undef PG8_MMA
#undef PG8_WAIT_V
#undef PG8_WAIT_L
#undef PG8_BAR
#undef PG8_SCHED
}
}

#include <hip/hip_bf16.h>
#include <cmath>
namespace attn_body {
using bf16=__hip_bfloat16;
using bf16x8=__attribute__((ext_vector_type(8)))short;
using s16x4=__attribute__((ext_vector_type(4)))short;
using f32x16=__attribute__((ext_vector_type(16)))float;
using u32x4=__attribute__((ext_vector_type(4)))unsigned;
using f32x4_t=__attribute__((ext_vector_type(4)))float;
constexpr int BATCH=8,NHEAD=8,SEQ=2048,D=64,DM=1024;
constexpr int NW=8,QBLK=32,QB=QBLK*NW,KVBLK=64,NQB=SEQ/QB;
constexpr int ATTN_PITCH=DM, ATTN_UNIT_ROWS=QB;
__device__ __forceinline__ int crow(int r,int hi){return (r&3)+8*(r>>2)+4*hi;}
#define SBAR() __builtin_amdgcn_sched_barrier(0)
__device__ __forceinline__ void cmask(f32x16&p0,f32x16&p1,int jb,int qrel,int hi){
  const float NEG=-INFINITY; int kb=64*jb+4*hi;
  #pragma unroll
  for(int r=0;r<16;++r){int kv=kb+(r&3)+8*(r>>2); if(kv>qrel)p0[r]=NEG; if(kv+32>qrel)p1[r]=NEG;}
}

constexpr int NSLOT=3, SLOTB=8192;
constexpr int LDS_K=0, LDS_V=NSLOT*SLOTB, LDS_WS=2*NSLOT*SLOTB, LDS_OST=LDS_WS+NW*64*4, LDS_DL=LDS_OST+NW*4096, LDS_WT=LDS_DL+SEQ*4, LDS_BYTES=LDS_WT+64;
constexpr float C2=0.125f*1.4426950408889634f;
__device__ __forceinline__ void glds16(const void*gsrc,unsigned lds_dst){unsigned keep;
  asm volatile("s_mov_b32 %0, m0\n\ts_mov_b32 m0, %2\n\ts_nop 0\n\tglobal_load_lds_dwordx4 %1, off\n\ts_mov_b32 m0, %0":"=&s"(keep):"v"(gsrc),"s"(lds_dst):"memory");}
__device__ __forceinline__ float max3f(float a,float b,float c){float r;asm("v_max3_f32 %0, %1, %2, %3":"=v"(r):"v"(a),"v"(b),"v"(c));return r;}
__device__ __forceinline__ float max2f(float a,float b){float r;asm("v_max_f32_e32 %0, %1, %2":"=v"(r):"v"(a),"v"(b));return r;}
__device__ __forceinline__ float fadd_s(float a,float b){float r;asm("v_add_f32_e32 %0, %1, %2":"=v"(r):"v"(a),"v"(b));return r;}
__device__ __forceinline__ float fsub_s(float a,float b){float r;asm("v_sub_f32_e32 %0, %1, %2":"=v"(r):"v"(a),"v"(b));return r;}
typedef float f32x2_t __attribute__((ext_vector_type(2))); typedef __bf16 bf16x2_t __attribute__((ext_vector_type(2)));
__device__ __forceinline__ unsigned cvtpk_s(float lo,float hi){f32x2_t v={lo,hi};bf16x2_t b=__builtin_convertvector(v,bf16x2_t);return __builtin_bit_cast(unsigned,b);}
#define WAIT_BAR(N) asm volatile("s_waitcnt vmcnt(" #N ") lgkmcnt(0)\n\ts_barrier":::"memory")

__device__ __forceinline__ void qkt(f32x16&p0,f32x16&p1,const char*Kslot,const bf16x8*qr,int r32,int hi){
  const char*kb=Kslot+hi*1024+r32*16;
  #pragma unroll
  for(int d0=0;d0<4;++d0){
    const bf16x8 b0=*reinterpret_cast<const bf16x8*>(kb+d0*2048);
    const bf16x8 b1=*reinterpret_cast<const bf16x8*>(kb+d0*2048+512);
    p0=__builtin_amdgcn_mfma_f32_32x32x16_bf16(b0,qr[d0],p0,0,0,0);p1=__builtin_amdgcn_mfma_f32_32x32x16_bf16(b1,qr[d0],p1,0,0,0);}
}
typedef __attribute__((address_space(3))) const char* lds_cptr;
typedef short v4i16_t __attribute__((ext_vector_type(4)));
__device__ __forceinline__ void kload8(bf16x8*kf,lds_cptr kp){
  kf[0]=*(const __attribute__((address_space(3))) bf16x8*)(kp);      kf[1]=*(const __attribute__((address_space(3))) bf16x8*)(kp+512);
  kf[2]=*(const __attribute__((address_space(3))) bf16x8*)(kp+2048); kf[3]=*(const __attribute__((address_space(3))) bf16x8*)(kp+2560);
  kf[4]=*(const __attribute__((address_space(3))) bf16x8*)(kp+4096); kf[5]=*(const __attribute__((address_space(3))) bf16x8*)(kp+4608);
  kf[6]=*(const __attribute__((address_space(3))) bf16x8*)(kp+6144); kf[7]=*(const __attribute__((address_space(3))) bf16x8*)(kp+6656);
}
__device__ __forceinline__ void kload2(bf16x8*kf,lds_cptr kp,int j){ kf[2*j]=*(const __attribute__((address_space(3))) bf16x8*)(kp+j*2048); kf[2*j+1]=*(const __attribute__((address_space(3))) bf16x8*)(kp+j*2048+512); }
__device__ __forceinline__ s16x4 vtr(lds_cptr p){ return __builtin_bit_cast(s16x4,__builtin_amdgcn_ds_read_tr16_b64_v4i16((__attribute__((address_space(3))) v4i16_t*)p)); }
__device__ __forceinline__ float rowmax(const f32x16&p0,const f32x16&p1){
  float a=max3f(p0[0],p0[1],p1[0]),b=max3f(p0[2],p0[3],p1[1]);a=max3f(a,p1[2],p1[3]);
  #pragma unroll
  for(int r=4;r<16;r+=4){a=max3f(a,p0[r],p0[r+1]);b=max3f(b,p0[r+2],p0[r+3]);a=max3f(a,p1[r],p1[r+1]);b=max3f(b,p1[r+2],p1[r+3]);}
  const float m=max2f(a,b);
  auto rr=__builtin_amdgcn_permlane32_swap(__float_as_uint(m),__float_as_uint(m),false,false);
  return max2f(__uint_as_float(rr[0]),__uint_as_float(rr[1]));
}
__device__ __forceinline__ void pv(f32x16*o,int vb,bf16x8 pa0,bf16x8 pa1,bf16x8 pa2,bf16x8 pa3){
  #pragma unroll
  for(int d0=0;d0<2;++d0){s16x4 lo[4],hi[4];
    #pragma unroll
    for(int ks=0;ks<4;++ks){
      asm volatile("ds_read_b64_tr_b16 %0,%1 offset:%c2":"=&v"(lo[ks]):"v"(vb),"i"(d0*4096+ks*1024):"memory");
      asm volatile("ds_read_b64_tr_b16 %0,%1 offset:%c2":"=&v"(hi[ks]):"v"(vb),"i"(d0*4096+ks*1024+512):"memory");}
    asm volatile("s_waitcnt lgkmcnt(0)":::"memory");SBAR();
    #define PK(k) (bf16x8){lo[k][0],lo[k][1],lo[k][2],lo[k][3],hi[k][0],hi[k][1],hi[k][2],hi[k][3]}
    o[d0]=__builtin_amdgcn_mfma_f32_32x32x16_bf16(pa0,PK(0),o[d0],0,0,0);
    o[d0]=__builtin_amdgcn_mfma_f32_32x32x16_bf16(pa1,PK(1),o[d0],0,0,0);
    o[d0]=__builtin_amdgcn_mfma_f32_32x32x16_bf16(pa2,PK(2),o[d0],0,0,0);
    o[d0]=__builtin_amdgcn_mfma_f32_32x32x16_bf16(pa3,PK(3),o[d0],0,0,0);
    #undef PK
  }
}

#ifndef ATTN_STORE16
#define ATTN_STORE16(p,v) (*(u32x4*)(p)=(v))
#endif
template<int THRL> __device__ __forceinline__ void attn_unit(int b,int h,int qb,const bf16*Q,const bf16*__restrict__ K,const bf16*__restrict__ V,bf16*O,const float*LF,float*SSQA,char*shm){
  const int tid=opaque_tid(),lane=tid&63,r32=lane&31,hi=lane>>5; const int wid=__builtin_amdgcn_readfirstlane(tid>>6);
  const long rowbase=(long)b*SEQ; const int q0=qb*QB;
  const bf16*Qw=Q+(rowbase+q0+wid*QBLK)*DM+h*D;
  const bf16*Kh=K+rowbase*DM+h*D,*Vh=V+rowbase*DM+h*D;
  const unsigned lds0=(unsigned)(uintptr_t)shm;
  float*wsf=(float*)(shm+LDS_WS)+wid*64;
  const bf16*ksrc=Kh+(long)lane*DM+wid*8;
  const bf16*vsrc=Vh+(long)(16*(wid&3)+(lane>>2))*DM+(wid>>2)*32+(lane&3)*8;
  const unsigned kdst=lds0+LDS_K+wid*1024, vdst=lds0+LDS_V+wid*1024;
  #define DMA_K(t,slot) glds16(ksrc+(long)(t)*KVBLK*DM,(unsigned)__builtin_amdgcn_readfirstlane(kdst+(slot)))
  #define DMA_V(t,slot) glds16(vsrc+(long)(t)*KVBLK*DM,(unsigned)__builtin_amdgcn_readfirstlane(vdst+(slot)))
  const int vb0=(int)(lds0+LDS_V)+((lane>>4)&1)*32+(lane&3)*8+(4*hi+((lane&15)>>2))*64;
  const char*Kbase=shm+LDS_K; bf16x8 kf[8];
  const lds_cptr shm3=(lds_cptr)shm; const lds_cptr kp0=shm3+LDS_K+hi*1024+r32*16; const lds_cptr vp0=shm3+LDS_V+((lane>>4)&1)*32+(lane&3)*8+(4*hi+((lane&15)>>2))*64;
  const int NT=(q0+QB)/KVBLK;
  DMA_K(0,0);DMA_V(0,0);DMA_K(1,SLOTB);
  bf16x8 qr[4];
  #pragma unroll
  for(int d0=0;d0<4;++d0)qr[d0]=*reinterpret_cast<const bf16x8*>(&Qw[(long)r32*DM+d0*16+hi*8]);
  float l_reg=0.f;f32x16 o[2];o[0]=f32x16{};o[1]=f32x16{};
  const int qrel=wid*QBLK+r32;
  #define CMASK(P0,P1,t) do{int jb_=(t)-(NT-4); if(jb_>=0)cmask(P0,P1,jb_,qrel,hi);}while(0)
  bool resc=false;
  #define START(P0,P1) do{ const float rm=rowmax(P0,P1); resc=false; \
    { const float dl=rm; nbq=fsub_s(nbq,dl); \
      _Pragma("unroll") for(int r=0;r<16;++r){P0[r]=fsub_s(P0[r],dl);P1[r]=fsub_s(P1[r],dl);} } \
    _Pragma("unroll") for(int r=0;r<16;++r)P0[r]=__builtin_amdgcn_exp2f(P0[r]); }while(0)
  #define RESC() do{ if(resc){ asm volatile("s_waitcnt lgkmcnt(0)":::"memory"); \
      _Pragma("unroll") for(int d_=0;d_<2;++d_) _Pragma("unroll") for(int r=0;r<16;++r)o[d_][r]*=wsf[crow(r,hi)]; } }while(0)
  f32x16 pA0,pA1,pB0,pB1;
  int sl_prev=0,sl_cur=0,sl_next=SLOTB;
  #define ROT() do{sl_prev=sl_cur;sl_cur=sl_next;sl_next=(sl_next==(NSLOT-1)*SLOTB)?0:sl_next+SLOTB;}while(0)
  DMA_K(2,2*SLOTB);
  { const int n=q0+QB; const float*lf=LF+(long)(b*NHEAD+h)*SEQ;
    f32x4_t v={0.f,0.f,0.f,0.f}; if(4*tid<n)v=*(const f32x4_t*)(lf+4*tid);
    v[1]+=v[0];v[2]+=v[1];v[3]+=v[2];
    float incl=v[3];
    #pragma unroll
    for(int o_=1;o_<64;o_<<=1){const float u_=__shfl_up(incl,o_);if(lane>=o_)incl+=u_;}
    const float excl=incl-v[3];
    __attribute__((address_space(3))) float*wt=(__attribute__((address_space(3))) float*)(shm+LDS_WT);
    if(lane==63)wt[wid]=incl;
    asm volatile("s_waitcnt lgkmcnt(0)\n\ts_barrier":::"memory");
    float pre=excl;
    #pragma unroll
    for(int w_=0;w_<NW;++w_){const float x_=wt[w_];if(w_<wid)pre+=x_;}
    if(4*tid<n){f32x4_t w4;w4[0]=v[0]+pre;w4[1]=v[1]+pre;w4[2]=v[2]+pre;w4[3]=v[3]+pre;*(__attribute__((address_space(3))) f32x4_t*)(shm+LDS_DL+16*tid)=w4;}
    asm volatile("s_waitcnt lgkmcnt(0)\n\ts_barrier":::"memory"); }
  const __attribute__((address_space(3))) char*dl0=(const __attribute__((address_space(3))) char*)(shm+LDS_DL)+hi*16;
  float nbq=((const __attribute__((address_space(3))) float*)(shm+LDS_DL))[q0+wid*QBLK+r32];
  #define BIAS(C0,C1,t) do{ const __attribute__((address_space(3))) f32x4_t*dp_=(const __attribute__((address_space(3))) f32x4_t*)(dl0+(t)*256); \
    _Pragma("unroll") for(int j_=0;j_<4;++j_){ const f32x4_t a_=dp_[2*j_],b_=dp_[2*j_+8]; \
      _Pragma("unroll") for(int i_=0;i_<4;++i_){C0[4*j_+i_]=nbq-a_[i_];C1[4*j_+i_]=nbq-b_[i_];} } }while(0)
  WAIT_BAR(3);
  BIAS(pA0,pA1,0);
  qkt(pA0,pA1,Kbase,qr,r32,hi);asm volatile("s_nop 15\n\ts_nop 7":"+v"(pA0),"+v"(pA1));CMASK(pA0,pA1,0);
  START(pA0,pA1);
  _Pragma("unroll") for(int r=0;r<16;++r)pA1[r]=__builtin_amdgcn_exp2f(pA1[r]);
  WAIT_BAR(0);
  DMA_K(3,0);DMA_V(1,SLOTB);
  ROT();
  kload8(kf,kp0+sl_cur);
  WAIT_BAR(2);
  s16x4 vlo[8],vhi[8]; u32x4 pw0,pw1,pw2,pw3;
  #define PKW(P,B) cvtpk_s(P[B],P[B+1])
  #define PAF(k) __builtin_bit_cast(bf16x8,pw##k)
  #define VFR(i) (bf16x8){vlo[i][0],vlo[i][1],vlo[i][2],vlo[i][3],vhi[i][0],vhi[i][1],vhi[i][2],vhi[i][3]}
  #define PIN(x) asm volatile("":"+v"(x))
  #define MX3(a,b,c) __builtin_fmaxf(__builtin_fmaxf((a),(b)),(c))
  #define GAPA(MF,A0,A1,A2,A3,W0,W1,PW) do{ MF; sacc+=A0; sacc+=A1; sacc+=A2; sacc+=A3; PIN(sacc); W0; W1; PIN(PW); SBAR(); }while(0)
  #define EX(v) __builtin_amdgcn_exp2f(v)
  #define GAPB(MF,X,B) do{ MF; X[B]=EX(X[B]); X[B+1]=EX(X[B+1]); X[B+2]=EX(X[B+2]); X[B+3]=EX(X[B+3]); PIN(X); SBAR(); }while(0)
  #define VRD(i) do{ vlo[i]=vtr(vp_+(((i)>>2)*4096+((i)&3)*1024)); vhi[i]=vtr(vp_+(((i)>>2)*4096+((i)&3)*1024+512)); }while(0)
  #define KRD(G,j) do{ if(G){ kload2(kf,kp0+sl_next,j); SBAR(); } }while(0)
  #define STEP(C0,C1,P0,P1,t,GK,GV,GL) do{ SBAR(); \
    const lds_cptr vp_=vp0+sl_prev; BIAS(C0,C1,t); \
    VRD(0); SBAR(); float sacc=(P0[0]+P0[1]); \
    GAPA(C0=__builtin_amdgcn_mfma_f32_32x32x16_bf16(kf[0],qr[0],C0,0,0,0), P0[2],P0[3],P0[4],P0[5],     pw0[0]=PKW(P0,0), pw0[1]=PKW(P0,2), pw0); \
    VRD(4); SBAR(); GAPA(C1=__builtin_amdgcn_mfma_f32_32x32x16_bf16(kf[1],qr[0],C1,0,0,0), P0[6],P0[7],P0[8],P0[9],     pw0[2]=PKW(P0,4), pw0[3]=PKW(P0,6), pw0); \
    VRD(1); SBAR(); GAPA(C0=__builtin_amdgcn_mfma_f32_32x32x16_bf16(kf[2],qr[1],C0,0,0,0),   P0[10],P0[11],P0[12],P0[13], pw1[0]=PKW(P0,8), pw1[1]=PKW(P0,10), pw1); \
    VRD(5); SBAR(); GAPA(C1=__builtin_amdgcn_mfma_f32_32x32x16_bf16(kf[3],qr[1],C1,0,0,0),   P0[14],P0[15],P1[0],P1[1],   pw1[2]=PKW(P0,12),pw1[3]=PKW(P0,14), pw1); \
    VRD(2); SBAR(); GAPA(C0=__builtin_amdgcn_mfma_f32_32x32x16_bf16(kf[4],qr[2],C0,0,0,0),   P1[2],P1[3],P1[4],P1[5],     pw2[0]=PKW(P1,0), pw2[1]=PKW(P1,2), pw2); \
    VRD(6); SBAR(); GAPA(C1=__builtin_amdgcn_mfma_f32_32x32x16_bf16(kf[5],qr[2],C1,0,0,0),   P1[6],P1[7],P1[8],P1[9],     pw2[2]=PKW(P1,4), pw2[3]=PKW(P1,6), pw2); \
    VRD(3); SBAR(); GAPA(C0=__builtin_amdgcn_mfma_f32_32x32x16_bf16(kf[6],qr[3],C0,0,0,0),   P1[10],P1[11],P1[12],P1[13], pw3[0]=PKW(P1,8), pw3[1]=PKW(P1,10), pw3); \
    VRD(7); SBAR(); GAPA(C1=__builtin_amdgcn_mfma_f32_32x32x16_bf16(kf[7],qr[3],C1,0,0,0),   P1[14],P1[15],0.f,0.f,       pw3[2]=PKW(P1,12),pw3[3]=PKW(P1,14), pw3); \
    l_reg+=sacc; \
    if(GK){DMA_K((t)+3,sl_cur);} if(GV){DMA_V((t)+1,sl_next);} \
    CMASK(C0,C1,t); \
    { float a=MX3(C0[0],C0[1],C1[0]),b=MX3(C0[2],C0[3],C1[1]); a=MX3(a,C1[2],C1[3]); \
      _Pragma("unroll") for(int r=4;r<16;r+=4){a=MX3(a,C0[r],C0[r+1]);b=MX3(b,C0[r+2],C0[r+3]);a=MX3(a,C1[r],C1[r+1]);b=MX3(b,C1[r+2],C1[r+3]);} \
      float rm=__builtin_fmaxf(a,b); { auto rr=__builtin_amdgcn_permlane32_swap(__float_as_uint(rm),__float_as_uint(rm),false,false); rm=__builtin_fmaxf(__uint_as_float(rr[0]),__uint_as_float(rr[1])); } \
      resc=false; \
      if(__any(rm>(float)THRL)){ const float dl=__builtin_fmaxf(rm,0.f); nbq-=dl; \
        _Pragma("unroll") for(int r=0;r<16;++r){C0[r]-=dl;C1[r]-=dl;} \
        const float f=__builtin_amdgcn_exp2f(-dl); l_reg*=f; if(hi==0)wsf[r32]=f; resc=true; } } \
    SBAR(); \
    GAPB(o[0]=__builtin_amdgcn_mfma_f32_32x32x16_bf16(PAF(0),VFR(0),o[0],0,0,0), C0,0); \
    GAPB(o[1]=__builtin_amdgcn_mfma_f32_32x32x16_bf16(PAF(0),VFR(4),o[1],0,0,0), C0,4); \
    KRD(GL,0); GAPB(o[0]=__builtin_amdgcn_mfma_f32_32x32x16_bf16(PAF(1),VFR(1),o[0],0,0,0), C0,8); \
    KRD(GL,1); GAPB(o[1]=__builtin_amdgcn_mfma_f32_32x32x16_bf16(PAF(1),VFR(5),o[1],0,0,0), C0,12); \
    KRD(GL,2); GAPB(o[0]=__builtin_amdgcn_mfma_f32_32x32x16_bf16(PAF(2),VFR(2),o[0],0,0,0), C1,0); \
    KRD(GL,3); GAPB(o[1]=__builtin_amdgcn_mfma_f32_32x32x16_bf16(PAF(2),VFR(6),o[1],0,0,0), C1,4); \
    GAPB(o[0]=__builtin_amdgcn_mfma_f32_32x32x16_bf16(PAF(3),VFR(3),o[0],0,0,0), C1,8); \
    GAPB(o[1]=__builtin_amdgcn_mfma_f32_32x32x16_bf16(PAF(3),VFR(7),o[1],0,0,0), C1,12); \
    }while(0)
  int t=1;
  #undef CMASK
  #define CMASK(P0,P1,t) do{}while(0)
  for(;t+5<NT;t+=2){
    STEP(pB0,pB1,pA0,pA1,t,true,true,true);     WAIT_BAR(2); RESC(); ROT();
    STEP(pA0,pA1,pB0,pB1,t+1,true,true,true);   WAIT_BAR(2); RESC(); ROT();
  }
  #undef CMASK
  #define CMASK(P0,P1,t) do{int jb_=(t)-(NT-4); if(jb_>=0)cmask(P0,P1,jb_,qrel,hi);}while(0)
  #define ENDW(tt) do{ if((tt)+3<NT){WAIT_BAR(2);} else if((tt)+2<NT){WAIT_BAR(1);} else {WAIT_BAR(0);} }while(0)
  for(;t+1<NT;t+=2){
    STEP(pB0,pB1,pA0,pA1,t,(t+3<NT),(t+1<NT),(t+1<NT));       ENDW(t);   RESC(); ROT();
    STEP(pA0,pA1,pB0,pB1,t+1,(t+4<NT),(t+2<NT),(t+2<NT));     ENDW(t+1); RESC(); ROT();
  }
  STEP(pB0,pB1,pA0,pA1,NT-1,false,false,false); RESC();
  { float sacc=pB0[0]+pB0[1]; _Pragma("unroll") for(int r=2;r<16;++r)sacc+=pB0[r]; _Pragma("unroll") for(int r=0;r<16;++r)sacc+=pB1[r]; l_reg+=sacc;
    pw0=(u32x4){PKW(pB0,0),PKW(pB0,2),PKW(pB0,4),PKW(pB0,6)};pw1=(u32x4){PKW(pB0,8),PKW(pB0,10),PKW(pB0,12),PKW(pB0,14)};pw2=(u32x4){PKW(pB1,0),PKW(pB1,2),PKW(pB1,4),PKW(pB1,6)};pw3=(u32x4){PKW(pB1,8),PKW(pB1,10),PKW(pB1,12),PKW(pB1,14)};
    SBAR(); pv(o,vb0+sl_cur,PAF(0),PAF(1),PAF(2),PAF(3)); }
  #undef PKW
  #undef PAF
  #undef VFR
  #undef PIN
  #undef MX3
  #undef GAPA
  #undef GAPB
  #undef EX
  #undef VRD
  #undef KRD
  #undef STEP
  #undef ENDW
  {auto rr=__builtin_amdgcn_permlane32_swap(__float_as_uint(l_reg),__float_as_uint(l_reg),false,false);l_reg=__uint_as_float(rr[0])+__uint_as_float(rr[1]);}
  if(hi==0)wsf[32+r32]=l_reg;asm volatile("s_waitcnt lgkmcnt(0)":::"memory");
  float rli[16];
  #pragma unroll
  for(int r=0;r<16;++r)rli[r]=__builtin_amdgcn_rcpf(wsf[32+crow(r,hi)]);
  bf16*Ow=O+(rowbase+q0+wid*QBLK)*DM+h*D;
  { bf16*stg=(bf16*)(shm+LDS_OST)+wid*2048;
    #pragma unroll
    for(int r=0;r<16;++r){const int orow=crow(r,hi);
      #pragma unroll
      for(int d0=0;d0<2;++d0)stg[orow*64+d0*32+r32]=__float2bfloat16(o[d0][r]*rli[r]);}
    asm volatile("s_waitcnt lgkmcnt(0)":::"memory");
    #pragma unroll
    for(int i=0;i<4;++i){const int row=i*8+(lane>>3),ch=lane&7; const u32x4 v=*(const u32x4*)(stg+row*64+ch*8); ATTN_STORE16(Ow+(long)row*DM+ch*8,v);
      float s_=0.f;
      #pragma unroll
      for(int e_=0;e_<4;++e_){const float lo_=__uint_as_float(v[e_]<<16),hi_=__uint_as_float(v[e_]&0xffff0000u);s_+=lo_*lo_+hi_*hi_;}
      s_+=__shfl_xor(s_,1);s_+=__shfl_xor(s_,2);s_+=__shfl_xor(s_,4);
      if(ch==0)SSQA[(rowbase+q0+wid*QBLK+row)*NHEAD+h]=s_;} }
  asm volatile("s_waitcnt lgkmcnt(0)\n\ts_barrier":::"memory");
  #undef DMA_K
  #undef DMA_V
  #undef CMASK
  #undef START
  #undef RESC
  #undef ROT
  #undef BIAS
}
constexpr int ATTN_LDS_BYTES=LDS_BYTES;
struct AttnTensors { const bf16* Q; const bf16* K; const bf16* V; bf16* O; const float* LF; float* SSQA; };
struct AttnUnit { int bh; int qb; };
struct StaticOrder {
  int vcu;
  __device__ __forceinline__ explicit StaticOrder(int grid,int block):vcu((block%8)*(grid/8)+block/8){}
  __device__ __forceinline__ bool next(int i,AttnUnit&u)const{ if(i>=2)return false; const int s=vcu&3; u.bh=vcu>>2; u.qb=(i==0)?7-s:s; return true; }
  __device__ __forceinline__ void a_ready(const AttnUnit&)const{}
  __device__ __forceinline__ void done(const AttnUnit&)const{}
};
template<class Sched,int THRL=8> __device__ __forceinline__ void attn_phase(char*lds,const AttnTensors&T,const Sched&S){
  AttnUnit u;
  for(int i=0;S.next(i,u);++i){ S.a_ready(u); attn_unit<THRL>(u.bh/NHEAD,u.bh%NHEAD,u.qb,T.Q,T.K,T.V,T.O,T.LF,T.SSQA,lds); S.done(u); }
}
#undef SBAR
#undef WAIT_BAR
}

constexpr int NWAVES = 8;

constexpr int BATCH = 8, SEQ = 2048, D = 1024, NH = 8, HD = 64, DFF = 2816, DCONV = 512, DATTN = 512, CONVW = 31, NIN = 2568, NINP = 2816;
constexpr int M = BATCH * SEQ;
constexpr float EPS = 1e-6f;
static_assert(DFF == FF_DIM, "act pitch");

constexpr size_t MiB = 1u << 20;
constexpr size_t WS_CTL = 0, CTL_ZERO_BYTES = 1 * MiB;
constexpr size_t WS_W13A = 2 * MiB, WS_W2A = 13 * MiB, WS_WIN = 19 * MiB, WS_WOUT = 25 * MiB, WS_W13B = 27 * MiB, WS_W2B = 38 * MiB;
constexpr size_t WS_LF = 45 * MiB;
constexpr size_t WS_RS0 = 46 * MiB;
constexpr size_t WS_SSQ1 = WS_RS0 + 256 * 1024, WS_SSQ2 = WS_SSQ1 + 256 * 1024, WS_SSQ3 = WS_SSQ2 + 256 * 1024;
constexpr size_t WS_SSQA = 47 * MiB;
constexpr size_t WS_XB = 48 * MiB;
constexpr size_t WS_ACT = 80 * MiB;
constexpr size_t WS_U = 80 * MiB, WS_KV = 96 * MiB, WS_Y = 128 * MiB;
constexpr size_t WS_END = 168 * MiB;
static_assert(WS_W13A + (size_t)2 * DFF * D * 2 <= WS_W2A && WS_W2A + (size_t)D * DFF * 2 <= WS_WIN && WS_WIN + (size_t)NINP * D * 2 <= WS_WOUT && WS_WOUT + (size_t)D * D * 2 <= WS_W13B &&
              WS_W13B + (size_t)2 * DFF * D * 2 <= WS_W2B && WS_W2B + (size_t)D * DFF * 2 <= WS_LF && WS_LF + (size_t)M * NH * 4 <= WS_RS0 && WS_SSQ3 + 256 * 1024 <= WS_SSQA && WS_SSQA + (size_t)M * NH * 4 <= WS_XB &&
              WS_XB + (size_t)M * D * 2 <= WS_ACT && WS_ACT + (size_t)M * DFF * 2 <= WS_END && WS_Y + (size_t)M * D * 2 <= WS_END && WS_U + (size_t)M * 512 * 2 <= WS_KV && WS_KV + (size_t)M * D * 2 <= WS_Y, "d_ws map");
constexpr int CW_TMO = 0, CW_CODE = 1;
constexpr int CW_BAR = 4096;

constexpr int RING_OFF = 0, RING_BYTES = 131072;
constexpr int LDSCTL_OFF = RING_BYTES, MISC_OFF = LDSCTL_OFF + 320;
constexpr int LDS_BYTES = 147456;
static_assert(MISC_OFF + 128 <= RSC_OFF && RSC_OFF + 1024 <= LDS_BYTES, "LDS map");

#define GAS __attribute__((address_space(1)))
#define LAS __attribute__((address_space(3)))
typedef unsigned short bf16;
typedef unsigned v4u __attribute__((ext_vector_type(4)));
typedef float f32x4 __attribute__((ext_vector_type(4)));
typedef short bf16x8 __attribute__((ext_vector_type(8)));
typedef GAS unsigned gu32;
typedef GAS unsigned long long gu64;
#define RLX_AGENT __ATOMIC_RELAXED, __HIP_MEMORY_SCOPE_AGENT
#define LDS_WAIT() asm volatile("s_waitcnt lgkmcnt(0)" ::: "memory")
#define VM_WAIT() asm volatile("s_waitcnt vmcnt(0)" ::: "memory")
__device__ __forceinline__ unsigned long long rt() { return __builtin_amdgcn_s_memrealtime(); }
__device__ __forceinline__ unsigned f2bf(float f) { unsigned u = __builtin_bit_cast(unsigned, f); return (u + 0x7fffu + ((u >> 16) & 1u)) >> 16; }
__device__ __forceinline__ unsigned pk2(float lo, float hi) { return f2bf(lo) | (f2bf(hi) << 16); }

#define XB_TMO      128
#define XB_XCNT(j)  (256  + 64 * (j))
#define XB_XSUB(j)  (1280 + 64 * (j))
#define XB_XGEN(j)  (2304 + 64 * (j))
#define XB_TOP      3328
#define XB_TOPGEN   3392
#define XCD_BAR_WORDS 3456
#define XB_SPIN_CAP (1u << 18)

__device__ __forceinline__ unsigned xb_ld(unsigned* p)              { return __hip_atomic_load(p, __ATOMIC_RELAXED, __HIP_MEMORY_SCOPE_AGENT); }
__device__ __forceinline__ unsigned xb_add(unsigned* p, unsigned v) { return __hip_atomic_fetch_add(p, v, __ATOMIC_RELAXED, __HIP_MEMORY_SCOPE_AGENT); }
__device__ __forceinline__ unsigned xb_xcc_id() { return (unsigned)__builtin_amdgcn_s_getreg((3 << 11) | 20) & 0xFu; }
#define XB_SPIN(cond, bar) do { unsigned _sp = 0; while (cond) { __builtin_amdgcn_s_sleep(1); \
    if ((++_sp & 255u) == 0u) { if (xb_ld(&(bar)[XB_TMO])) break; if (_sp > XB_SPIN_CAP) { atomicAdd(&(bar)[XB_TMO], 1u); break; } } } } while (0)

struct XcdBarrier {
    unsigned* bar; unsigned x;
    volatile LAS unsigned* st;
};

__device__ __forceinline__ XcdBarrier xcd_barrier_post(unsigned* bar, volatile LAS unsigned* st) {
    XcdBarrier b; b.bar = bar; b.x = xb_xcc_id(); b.st = st;
    if (threadIdx.x == 0) (void)xb_add(&bar[XB_XCNT(b.x)], 1u);
    return b;
}
__device__ __forceinline__ void xcd_barrier_complete(unsigned* bar, unsigned x, unsigned& nloc, unsigned& nx) {
    const unsigned G = gridDim.x * gridDim.y * gridDim.z;
    unsigned sum, cnt, mine, sp = 0u;
    for (;;) {
        sum = 0u; cnt = 0u; mine = 0u;
#pragma unroll
        for (unsigned j = 0; j < 16; ++j) { const unsigned c = xb_ld(&bar[XB_XCNT(j)]); sum += c; cnt += (c > 0u) ? 1u : 0u; mine = (j == x) ? c : mine; }
        if (sum == G) break;
        __builtin_amdgcn_s_sleep(1);
        if ((++sp & 255u) == 0u) { if (xb_ld(&bar[XB_TMO])) break; if (sp > XB_SPIN_CAP) { atomicAdd(&bar[XB_TMO], 1u); break; } }
    }
    nloc = mine > 0u ? mine : 1u; nx = cnt > 0u ? cnt : 1u;
}

__device__ __forceinline__ void xcd_barrier(const XcdBarrier& b) {
    asm volatile("s_waitcnt vmcnt(0)" ::: "memory");
    __syncthreads();
    if (threadIdx.x == 0) {
        unsigned* bar = b.bar;
        __builtin_amdgcn_s_waitcnt(0);
        unsigned nloc = b.st[0], nx = b.st[1];
        if (nloc == 0u) { xcd_barrier_complete(bar, b.x, nloc, nx); b.st[0] = nloc; b.st[1] = nx; }
        const unsigned old = xb_add(&bar[XB_XSUB(b.x)], 1u);
        const unsigned gen = old / nloc;
        if (old + 1u == (gen + 1u) * nloc) {
            __builtin_amdgcn_fence(__ATOMIC_RELEASE, "agent");
            asm volatile("s_waitcnt vmcnt(0)" ::: "memory");
            const unsigned og = xb_add(&bar[XB_TOP], 1u);
            const unsigned tg = og / nx;
            if (og + 1u == (tg + 1u) * nx) xb_add(&bar[XB_TOPGEN], 1u);
            else XB_SPIN(xb_ld(&bar[XB_TOPGEN]) == tg, bar);
            __builtin_amdgcn_fence(__ATOMIC_ACQUIRE, "agent");
            xb_add(&bar[XB_XGEN(b.x)], 1u);
            asm volatile("s_waitcnt vmcnt(0)" ::: "memory");
        } else {
            XB_SPIN(xb_ld(&bar[XB_XGEN(b.x)]) == gen, bar);
            __builtin_amdgcn_fence(__ATOMIC_ACQUIRE, "agent");
            asm volatile("s_waitcnt vmcnt(0)" ::: "memory");
        }
    }
    __syncthreads();
}

struct Frame {
    LAS unsigned char* lds;
    volatile LAS unsigned* MISC;
    gu32* ctl;
    int tid, lane, wave;
    int vcu, G;
    const float* x; float* out;
    const float *g1, *w13a, *w2a, *gmix, *win, *cw, *cb, *lng, *lnb, *fb, *gyc, *gya, *wout, *g2, *w13b, *w2b, *gfin;
    bf16 *W13A, *W2A, *WIN, *WOUT, *W13B, *W2B;
    bf16 *XB, *ACT, *U, *KV, *Y;
    float *LF, *RS0, *SSQ1, *SSQ2, *SSQ3, *SSQA;
};

#define FRAME_REFRESH(F) do { (F).tid = opaque_tid(); (F).lane = (F).tid & 63; (F).wave = __builtin_amdgcn_readfirstlane((F).tid >> 6); } while (0)
__device__ __forceinline__ float wave_sum(float v) {
#pragma unroll
    for (int o = 1; o < 64; o <<= 1) v += __shfl_xor(v, o);
    return v;
}
constexpr int CVT_TS = 144;
__device__ __forceinline__ void cvt_item(const float* W, int N, int K, bf16* WT, int k0, int n0d, int csrc, int nvalid, int kxor, const float* gain, LAS unsigned char* T, int lane) {
    const int kq = lane >> 4, nq = lane & 15;
    f32x4 v[16];
    const bool ok = 4 * nq < nvalid;
#pragma unroll
    for (int i = 0; i < 16; ++i) { const int kd = k0 + 16 * kq + i; v[i] = ok ? *(const GAS f32x4*)(W + (size_t)(kd ^ kxor) * N + csrc + 4 * nq) : (f32x4){0.f, 0.f, 0.f, 0.f}; }
    if (gain) {
#pragma unroll
        for (int q = 0; q < 4; ++q) { const f32x4 g = *(const GAS f32x4*)(gain + 16 * kq + 4 * q); v[4 * q] = v[4 * q] * g.x; v[4 * q + 1] = v[4 * q + 1] * g.y; v[4 * q + 2] = v[4 * q + 2] * g.z; v[4 * q + 3] = v[4 * q + 3] * g.w; }
    }
#pragma unroll
    for (int c = 0; c < 4; ++c) {
        v4u a, b;
        a.x = pk2(v[0][c], v[1][c]); a.y = pk2(v[2][c], v[3][c]); a.z = pk2(v[4][c], v[5][c]); a.w = pk2(v[6][c], v[7][c]);
        b.x = pk2(v[8][c], v[9][c]); b.y = pk2(v[10][c], v[11][c]); b.z = pk2(v[12][c], v[13][c]); b.w = pk2(v[14][c], v[15][c]);
        LAS v4u* d = (LAS v4u*)(T + (4 * nq + c) * CVT_TS + 32 * kq); d[0] = a; d[1] = b;
    }
    LDS_WAIT(); asm volatile("" ::: "memory");
#pragma unroll
    for (int jj = 0; jj < 8; ++jj) { const int n = 8 * jj + (lane >> 3), ch = lane & 7; const v4u o = *(const LAS v4u*)(T + n * CVT_TS + 16 * ch); *(GAS v4u*)(WT + (size_t)(n0d + n) * K + k0 + 8 * ch) = o; }
    LDS_WAIT(); asm volatile("" ::: "memory");
}
constexpr int CI_13 = (D / 64) * (2 * DFF / 64), CI_2 = (DFF / 64) * (D / 64), CI_IN = (D / 64) * (NINP / 64), CI_OUT = (D / 64) * (D / 64);
__device__ __forceinline__ void cvt_w13(Frame& F, const float* W, const float* g, bf16* WT, int r, LAS unsigned char* T) {
    const int nblk = 2 * DFF / 64, kb = r / nblk, nb = r % nblk, n0d = 64 * nb, t = n0d >> 8, o = n0d & 255;
    const int csrc = (o < 128) ? 128 * t + o : DFF + 128 * t + (o - 128);
    cvt_item(W, 2 * DFF, D, WT, 64 * kb, n0d, csrc, 64, 0, g + 64 * kb, T, F.lane);
}
__device__ __forceinline__ void cvt_w2(Frame& F, const float* W, bf16* WT, int r, LAS unsigned char* T) {
    const int nblk = D / 64, kb = r / nblk, nb = r % nblk;
    cvt_item(W, D, DFF, WT, 64 * kb, 64 * nb, 64 * nb, 64, 0, nullptr, T, F.lane);
}
__device__ __forceinline__ void cvt_win(Frame& F, int r, LAS unsigned char* T) {
    const int nblk = NINP / 64, kb = r / nblk, nb = r % nblk, n0d = 64 * nb; int csrc, nvalid = 64;
    if (n0d < 1024) { const int t = n0d >> 8, o = n0d & 255; csrc = (o < 128) ? 128 * t + o : 512 + 128 * t + (o - 128); }
    else if (n0d < 2560) csrc = n0d;
    else if (n0d == 2560) { csrc = 2560; nvalid = 8; }
    else { csrc = 0; nvalid = 0; }
    cvt_item(F.win, NIN, D, F.WIN, 64 * kb, n0d, csrc, nvalid, 0, F.gmix + 64 * kb, T, F.lane);
}
__device__ __forceinline__ void cvt_wout(Frame& F, int r, LAS unsigned char* T) {
    const int nblk = D / 64, kb = r / nblk, nb = r % nblk, k0 = 64 * kb;
    cvt_item(F.wout, D, D, F.WOUT, k0, 64 * nb, 64 * nb, 64, 512, (k0 < 512) ? F.gya + k0 : F.gyc + (k0 - 512), T, F.lane);
}
__device__ __forceinline__ void cvt_jobs(Frame& F, int first_mat, int last_mat, int wrank, int nw) {
    LAS unsigned char* T = F.lds + RING_OFF + F.wave * 16384;
    int base = 0;
    for (int mat = first_mat; mat <= last_mat; ++mat) {
        const int cnt = (mat == 0 || mat == 4) ? CI_13 : (mat == 1 || mat == 5) ? CI_2 : (mat == 2) ? CI_IN : CI_OUT;
        int r0 = (wrank - base % nw + nw) % nw;
        for (int r = r0; r < cnt; r += nw) {
            if (mat == 0) cvt_w13(F, F.w13a, F.g1, F.W13A, r, T);
            else if (mat == 1) cvt_w2(F, F.w2a, F.W2A, r, T);
            else if (mat == 2) cvt_win(F, r, T);
            else if (mat == 3) cvt_wout(F, r, T);
            else if (mat == 4) cvt_w13(F, F.w13b, F.g2, F.W13B, r, T);
            else cvt_w2(F, F.w2b, F.W2B, r, T);
        }
        base += cnt;
    }
}
__device__ __forceinline__ void p0_rows(Frame& F, int gw, int NGW) {
    for (int m0 = gw; m0 < M; m0 += 4 * NGW) {
        f32x4 v[4][4];
#pragma unroll
        for (int q = 0; q < 4; ++q) { const int m = m0 + q * NGW; if (m < M) { const GAS f32x4* xr = (const GAS f32x4*)(F.x + (size_t)m * D) + F.lane;
#pragma unroll
            for (int j = 0; j < 4; ++j) v[q][j] = xr[64 * j]; } }
#pragma unroll
        for (int q = 0; q < 4; ++q) { const int m = m0 + q * NGW; if (m < M) { float s = 0.f;
#pragma unroll
            for (int j = 0; j < 4; ++j) s += (v[q][j].x * v[q][j].x + v[q][j].y * v[q][j].y) + (v[q][j].z * v[q][j].z + v[q][j].w * v[q][j].w);
            s = wave_sum(s);
            GAS unsigned long long* o8 = (GAS unsigned long long*)(F.XB + (size_t)m * D) + F.lane;
#pragma unroll
            for (int j = 0; j < 4; ++j) o8[64 * j] = (unsigned long long)pk2(v[q][j].x, v[q][j].y) | ((unsigned long long)pk2(v[q][j].z, v[q][j].w) << 32);
            if (F.lane == 0) F.RS0[m] = 1.0f / sqrtf(s * (1.0f / D) + EPS); } }
    }
}
#ifndef CVT_SPREAD
#define CVT_SPREAD 1
#endif
__device__ __forceinline__ void p0_prologue(Frame& F) {
    const int gw = F.vcu * NWAVES + F.wave, NGW = F.G * NWAVES;
    cvt_jobs(F, 0, CVT_SPREAD ? 0 : 5, gw, NGW);
    p0_rows(F, gw, NGW);
}
constexpr int CV_ROWS = 64 + CONVW - 1, STAT_OFF = 131072 + 2048;
static_assert(CV_ROWS * 1024 <= RING_BYTES && STAT_OFF + 1024 <= LDS_BYTES, "conv LDS");
__device__ __forceinline__ void conv_unit(Frame& F, int tile) {
    typedef float f32x2v __attribute__((ext_vector_type(2)));
    const int t0 = tile * 64, s0 = t0 & (SEQ - 1);
    LAS unsigned char* ub = F.lds + RING_OFF;
    for (int i = F.wave; i < CV_ROWS; i += NWAVES) {
        v4u v = (v4u){0u, 0u, 0u, 0u};
        if (s0 - (CONVW - 1) + i >= 0) v = *(const GAS v4u*)((const GAS unsigned char*)F.U + (size_t)(t0 - (CONVW - 1) + i) * 1024 + F.lane * 16);
        *(LAS v4u*)(ub + i * 1024 + F.lane * 16) = v;
    }
    const int cp = F.tid & 255, th = F.tid >> 8;
    f32x2v w[CONVW];
#pragma unroll
    for (int j = 0; j < CONVW; ++j) w[j] = *(const GAS f32x2v*)(F.cw + j * DCONV + 2 * cp);
    const f32x2v bias = *(const GAS f32x2v*)(F.cb + 2 * cp);
    LDS_WAIT(); __syncthreads();
    f32x2v acc[32];
    const LAS unsigned* up = (const LAS unsigned*)(ub + (32 * th) * 1024 + cp * 4);
#pragma unroll
    for (int k = 0; k < 4; ++k) {
        f32x2v a[8];
#pragma unroll
        for (int i = 0; i < 8; ++i) a[i] = bias;
#pragma unroll
        for (int rr = 0; rr < 8 + CONVW - 1; ++rr) {
            const unsigned x = up[(8 * k + rr) * 256];
            const f32x2v u = (f32x2v){__uint_as_float(x << 16), __uint_as_float(x & 0xffff0000u)};
#pragma unroll
            for (int i = 0; i < 8; ++i) { const int j = rr - i; if (j >= 0 && j < CONVW) a[i] += w[j] * u; }
        }
#pragma unroll
        for (int i = 0; i < 8; ++i) acc[8 * k + i] = a[i];
    }
    __syncthreads();
    LAS float* part = (LAS float*)ub;
#pragma unroll
    for (int tk = 0; tk < 32; ++tk) { const f32x2v a = acc[tk]; part[((th * 32 + tk) * 2) * 256 + cp] = a.x + a.y; part[((th * 32 + tk) * 2 + 1) * 256 + cp] = a.x * a.x + a.y * a.y; }
    LDS_WAIT(); __syncthreads();
    LAS f32x2v* stat = (LAS f32x2v*)(F.lds + STAT_OFF); LAS float* stat2 = (LAS float*)(F.lds + STAT_OFF + 512);
    {   const int row = F.tid >> 2, qd = F.tid & 3; const LAS f32x4* rp = (const LAS f32x4*)(ub + row * 1024 + qd * 256); float s = 0.f;
#pragma unroll
        for (int i = 0; i < 16; ++i) { const f32x4 v = rp[(i + F.lane) & 15]; s += (v.x + v.y) + (v.z + v.w); }
        s += __shfl_xor(s, 1); s += __shfl_xor(s, 2);
        const float sq = __shfl_down(s, 4);
        if ((F.tid & 7) == 0) { const float mean = s * (1.0f / DCONV), var = fmaxf(sq * (1.0f / DCONV) - mean * mean, 0.f); stat[F.tid >> 3] = (f32x2v){mean, 1.0f / sqrtf(var + EPS)}; } }
    LDS_WAIT(); __syncthreads();
    const f32x2v lg = *(const GAS f32x2v*)(F.lng + 2 * cp), lb = *(const GAS f32x2v*)(F.lnb + 2 * cp);
#pragma unroll
    for (int tk = 0; tk < 32; ++tk) { const f32x2v st = stat[th * 32 + tk]; f32x2v v = (acc[tk] - st.x) * st.y * lg + lb; v.x = v.x * pg8::sigmoid_f(v.x); v.y = v.y * pg8::sigmoid_f(v.y); acc[tk] = v;
        part[(th * 32 + tk) * 256 + cp] = v.x * v.x + v.y * v.y; }
    LDS_WAIT(); __syncthreads();
    {   const int row = F.tid >> 3, e = F.tid & 7; const LAS f32x4* rp = (const LAS f32x4*)(ub + row * 1024 + e * 128); float s = 0.f;
#pragma unroll
        for (int i = 0; i < 8; ++i) { const f32x4 v = rp[(i + F.lane + (F.lane >> 3)) & 7]; s += (v.x + v.y) + (v.z + v.w); }
        s += __shfl_xor(s, 1); s += __shfl_xor(s, 2); s += __shfl_xor(s, 4);
        if (e == 0) stat2[row] = 1.0f / sqrtf(s * (1.0f / DCONV) + EPS); }
    LDS_WAIT(); __syncthreads();
    GAS unsigned* yo = (GAS unsigned*)(F.Y + (size_t)(t0 + th * 32) * D + 512 + 2 * cp);
#pragma unroll
    for (int tk = 0; tk < 32; ++tk) { const float r = stat2[th * 32 + tk]; yo[(size_t)tk * (D / 2)] = pk2(acc[tk].x * r, acc[tk].y * r); }
}
__device__ __forceinline__ void final_rows(Frame& F) {
    const int gw = F.vcu * NWAVES + F.wave, NGW = F.G * NWAVES;
    const GAS f32x4* g4 = (const GAS f32x4*)F.gfin + F.lane;
    for (int m = gw; m < M; m += NGW) {
        const f32x4 p = *(const GAS f32x4*)(F.SSQ3 + 4 * (size_t)m);
        const float r = 1.0f / sqrtf(((p.x + p.y) + (p.z + p.w)) * (1.0f / D) + EPS);
        GAS f32x4* xr = (GAS f32x4*)(F.out + (size_t)m * D) + F.lane;
#pragma unroll
        for (int j = 0; j < 4; ++j) { const f32x4 v = xr[64 * j], g = g4[64 * j]; xr[64 * j] = v * r * g; }
    }
}

#ifndef PH_MASK
#define PH_MASK 0x1ff
#endif
#define PH(k) ((PH_MASK >> (k)) & 1)
#ifndef REP_MASK
#define REP_MASK 0
#endif
#ifndef REP_N
#define REP_N 1
#endif
#define NREP(k) (1 + (((REP_MASK >> (k)) & 1) ? REP_N : 0))
#ifndef EXTRA_BARS
#define EXTRA_BARS 0
#endif
struct Args { const float* in[18]; float* out; unsigned char* ws; };
__global__ void __launch_bounds__(NWAVES * 64, 2) mk_fwd(Args args) {
    extern __shared__ __attribute__((aligned(16))) unsigned char lds[];
    Frame F;
    F.lds = (LAS unsigned char*)lds;
    F.MISC = (volatile LAS unsigned*)(F.lds + MISC_OFF);
    F.tid = threadIdx.x; F.lane = F.tid & 63; F.wave = __builtin_amdgcn_readfirstlane(F.tid >> 6);
    F.G = gridDim.x; { const int bx = blockIdx.x; F.vcu = (F.G % 8 == 0) ? (bx % 8) * (F.G / 8) + bx / 8 : bx; }
    unsigned char* ws = args.ws;
    F.ctl = (gu32*)(ws + WS_CTL);
    F.x = args.in[0]; F.g1 = args.in[1]; F.w13a = args.in[2]; F.w2a = args.in[3]; F.gmix = args.in[4]; F.win = args.in[5]; F.cw = args.in[6]; F.cb = args.in[7]; F.lng = args.in[8]; F.lnb = args.in[9];
    F.fb = args.in[10]; F.gyc = args.in[11]; F.gya = args.in[12]; F.wout = args.in[13]; F.g2 = args.in[14]; F.w13b = args.in[15]; F.w2b = args.in[16]; F.gfin = args.in[17]; F.out = args.out;
    F.W13A = (bf16*)(ws + WS_W13A); F.W2A = (bf16*)(ws + WS_W2A); F.WIN = (bf16*)(ws + WS_WIN); F.WOUT = (bf16*)(ws + WS_WOUT); F.W13B = (bf16*)(ws + WS_W13B); F.W2B = (bf16*)(ws + WS_W2B);
    F.XB = (bf16*)(ws + WS_XB); F.ACT = (bf16*)(ws + WS_ACT); F.U = (bf16*)(ws + WS_U); F.KV = (bf16*)(ws + WS_KV); F.Y = (bf16*)(ws + WS_Y);
    F.LF = (float*)(ws + WS_LF); F.RS0 = (float*)(ws + WS_RS0); F.SSQ1 = (float*)(ws + WS_SSQ1); F.SSQ2 = (float*)(ws + WS_SSQ2); F.SSQ3 = (float*)(ws + WS_SSQ3); F.SSQA = (float*)(ws + WS_SSQA);
    for (int u = F.tid; u < (LDS_BYTES - LDSCTL_OFF) / 4; u += NWAVES * 64) ((LAS unsigned*)(F.lds + LDSCTL_OFF))[u] = 0u;
    __syncthreads();
    XcdBarrier bar = xcd_barrier_post((unsigned*)(F.ctl + CW_BAR), F.MISC + 8);
#define GRID_BAR() xcd_barrier(bar)

    for (int rep_ = 0; rep_ < NREP(0); ++rep_) { if (rep_) GRID_BAR();
    if (PH(0)) { FRAME_REFRESH(F); p0_prologue(F); }
    }
    GRID_BAR();
    for (int rep_ = 0; rep_ < NREP(1); ++rep_) { if (rep_) GRID_BAR();
    if (PH(1)) {   pg8::Gemm g{F.XB, F.W13A, M, 2 * DFF, D}; pg8::StaticOrder S; S.init(M, 2 * DFF, F.G, (int)blockIdx.x);
        pg8::EpiSwiglu<1> E{F.ACT, F.RS0};
        pg8::gemm_phase<pg8::EpiSwiglu<1>, pg8::StaticOrder, true, true>(F.lds + RING_OFF, g, S, E);
        if (CVT_SPREAD && rep_ == 0 && (int)blockIdx.x >= 128) { FRAME_REFRESH(F); __syncthreads(); cvt_jobs(F, 1, 3, ((int)blockIdx.x - 128) * NWAVES + F.wave, 128 * NWAVES); } }
    }
    GRID_BAR();
    for (int rep_ = 0; rep_ < NREP(2); ++rep_) { if (rep_) GRID_BAR();
    if (PH(2)) {   pg8::Gemm g{F.ACT, F.W2A, M, D, DFF}; pg8::StaticOrder S; S.init(M, D, F.G, (int)blockIdx.x);
        pg8::EpiResid<0> E{F.x, F.out, F.XB, F.SSQ1, 0.5f};
        pg8::gemm_phase<pg8::EpiResid<0>, pg8::StaticOrder, false, true>(F.lds + RING_OFF, g, S, E); }
    }
    GRID_BAR();
    for (int rep_ = 0; rep_ < NREP(3); ++rep_) { if (rep_) GRID_BAR();
    if (PH(3)) {   pg8::Gemm g{F.XB, F.WIN, M, NINP, D}; pg8::StaticOrder S; S.init(M, NINP, F.G, (int)blockIdx.x);
        pg8::EpiInProj E{F.U, F.Y, F.KV, F.LF, F.SSQ1, F.fb, attn_body::C2};
        pg8::gemm_phase<pg8::EpiInProj, pg8::StaticOrder, true, true>(F.lds + RING_OFF, g, S, E);
        if (CVT_SPREAD && rep_ == 0 && (int)blockIdx.x >= 192) { FRAME_REFRESH(F); __syncthreads(); cvt_jobs(F, 4, 4, ((int)blockIdx.x - 192) * NWAVES + F.wave, 64 * NWAVES); } }
    }
    GRID_BAR();
    if (PH(4)) {
#ifndef NO_CONV
        for (int rep_ = 0; rep_ < NREP(4); ++rep_) { FRAME_REFRESH(F); conv_unit(F, F.vcu); __syncthreads(); }
#endif
#ifndef NO_ATTN
        static_assert(attn_body::ATTN_LDS_BYTES <= RING_BYTES && attn_body::ATTN_PITCH == D, "attention body geometry vs frame");
        const attn_body::AttnTensors AT{(const attn_body::bf16*)F.Y, (const attn_body::bf16*)F.KV, (const attn_body::bf16*)(F.KV + 512), (attn_body::bf16*)F.Y, F.LF, F.SSQA};
        const attn_body::StaticOrder S((int)F.G, (int)blockIdx.x);
        attn_body::attn_phase<attn_body::StaticOrder>((char*)lds + RING_OFF, AT, S);
#endif
    }
    GRID_BAR();
    if (PH(5)) {
        FRAME_REFRESH(F);
        pg8::Gemm g{F.Y, F.WOUT, M, D, D}; pg8::StaticOrder S; S.init(M, D, F.G, (int)blockIdx.x);
        pg8::Unit u0; S.next(0, u0);
        if (F.tid < 256) { const GAS f32x4* p = (const GAS f32x4*)(F.SSQA + (size_t)(u0.pm * 256 + F.tid) * NH); const f32x4 a = p[0], b = p[1];
            ((LAS float*)(F.lds + RSC_OFF))[F.tid] = 1.0f / sqrtf((((a.x + a.y) + (a.z + a.w)) + ((b.x + b.y) + (b.z + b.w))) * (1.0f / DATTN) + EPS); }
        LDS_WAIT(); __syncthreads();
        pg8::EpiResid<8> E{F.out, F.out, F.XB, F.SSQ2, 1.0f};
        pg8::gemm_phase<pg8::EpiResid<8>, pg8::StaticOrder, false, true>(F.lds + RING_OFF, g, S, E); }
    GRID_BAR();
    for (int rep_ = 0; rep_ < NREP(6); ++rep_) { if (rep_) GRID_BAR();
    if (PH(6)) {   pg8::Gemm g{F.XB, F.W13B, M, 2 * DFF, D}; pg8::StaticOrder S; S.init(M, 2 * DFF, F.G, (int)blockIdx.x);
        pg8::EpiSwiglu<4> E{F.ACT, F.SSQ2};
        pg8::gemm_phase<pg8::EpiSwiglu<4>, pg8::StaticOrder, true, true>(F.lds + RING_OFF, g, S, E);
        if (CVT_SPREAD && rep_ == 0 && (int)blockIdx.x >= 128) { FRAME_REFRESH(F); __syncthreads(); cvt_jobs(F, 5, 5, ((int)blockIdx.x - 128) * NWAVES + F.wave, 128 * NWAVES); } }
    }
    GRID_BAR();
    if (PH(7)) {   pg8::Gemm g{F.ACT, F.W2B, M, D, DFF}; pg8::StaticOrder S; S.init(M, D, F.G, (int)blockIdx.x);
        pg8::EpiResid<0> E{F.out, F.out, nullptr, F.SSQ3, 0.5f};
        pg8::gemm_phase<pg8::EpiResid<0>, pg8::StaticOrder, false, true>(F.lds + RING_OFF, g, S, E); }
    GRID_BAR();
    for (int eb_ = 0; eb_ < EXTRA_BARS; ++eb_) GRID_BAR();
    if (PH(8)) { FRAME_REFRESH(F); final_rows(F); }
}

extern "C" void kernel_launch(void* const* d_in, const int* in_sizes, int n_in, void* d_out, int out_size, void* d_ws, size_t ws_size, hipStream_t stream) {
    static int grid = 0;
    if (grid == 0) {
        if (n_in != 18 || in_sizes[0] != M * D || out_size != M * D || ws_size < WS_END) { fprintf(stderr, "kernel_launch: unexpected shapes (n_in %d, in0 %d, out %d, ws %zu); nothing launched\n", n_in, n_in > 0 ? in_sizes[0] : -1, out_size, ws_size); grid = -1; return; }
        int dev = 0, cus = 0, per_cu = 0;
        if (hipGetDevice(&dev) != hipSuccess || hipDeviceGetAttribute(&cus, hipDeviceAttributeMultiprocessorCount, dev) != hipSuccess) { fprintf(stderr, "kernel_launch: device query failed\n"); grid = -1; return; }
        if (hipFuncSetAttribute((const void*)mk_fwd, hipFuncAttributeMaxDynamicSharedMemorySize, LDS_BYTES) != hipSuccess) { fprintf(stderr, "kernel_launch: hipFuncSetAttribute failed\n"); grid = -1; return; }
        if (hipOccupancyMaxActiveBlocksPerMultiprocessor(&per_cu, (const void*)mk_fwd, NWAVES * 64, LDS_BYTES) != hipSuccess || per_cu < 1) { fprintf(stderr, "kernel_launch: occupancy query reports %d workgroups per CU; nothing launched\n", per_cu); (void)hipGetLastError(); grid = -1; return; }
        (void)hipGetLastError();
        grid = cus;
        if (grid != 256) { fprintf(stderr, "kernel_launch: %d CUs; this kernel is built for 256\n", grid); grid = -1; return; }
    }
    if (grid < 0) return;
    if (hipMemsetAsync((char*)d_ws + WS_CTL, 0, CTL_ZERO_BYTES, stream) != hipSuccess) { fprintf(stderr, "kernel_launch: hipMemsetAsync failed\n"); return; }
    Args a{};
    for (int i = 0; i < 18; ++i) a.in[i] = (const float*)d_in[i];
    a.out = (float*)d_out; a.ws = (unsigned char*)d_ws;
    hipLaunchKernelGGL(mk_fwd, dim3(grid), dim3(NWAVES * 64), LDS_BYTES, stream, a);
    const hipError_t le = hipPeekAtLastError();
    if (le != hipSuccess) fprintf(stderr, "kernel_launch: launch failed: %s\n", hipGetErrorName(le));
}
```
